# Optimizing an MI355X kernel written in HIP

```python
import jax, jax.numpy as jnp
from jax import lax
import numpy as np

D_MODEL = 1024
BATCH = 8
SEQ = 8192
DEPTH = 2

GRID_W = 64
CTX_LEN = 256
N_HEADS = 8
N_KV_HEADS = 2
HEAD_DIM = 64
Q_GROUP = N_HEADS // N_KV_HEADS
ATTN_W = N_HEADS * HEAD_DIM
KV_W = N_KV_HEADS * HEAD_DIM
ROPE_AXIS_DIM = HEAD_DIM // 2
ROPE_BASE = 10000.0
Q_BLOCK = 128
CONV_W = D_MODEL - ATTN_W
MIX_IN_W = ATTN_W + 2 * KV_W + 3 * CONV_W
MIX_OUT_IN = ATTN_W + CONV_W
POOL_WINDOWS = (2, 4, 8, 16)
N_POOL_GROUPS = len(POOL_WINDOWS)
POOL_GROUP_W = D_MODEL // N_POOL_GROUPS
D_FF = 2816
N_EXPERTS = 8
TOP_K = 2
D_FF_EXPERT = 1408
N_MOD = 6
N_EVEN = (DEPTH + 1) // 2
N_ODD = DEPTH // 2
EPS = 1e-6

kernel_name = "hybrid_dit_attn_conv_pool_moe"


def rms_norm(x, g):
    xf = x.astype(jnp.float32)
    y = xf * lax.rsqrt(jnp.mean(xf * xf, axis=-1, keepdims=True) + EPS)
    return (y * g.astype(jnp.float32)).astype(x.dtype)


def modulate(h, shift, scale):
    return h * (1 + scale) + shift


def adaln(cvec, w, b):
    return jnp.split(jax.nn.silu(cvec) @ w + b, N_MOD, axis=-1)


def axial_rope_tables(n_tokens):
    rows = n_tokens // GRID_W
    row = jnp.broadcast_to(jnp.arange(rows)[:, None], (rows, GRID_W)).reshape(-1)
    col = jnp.broadcast_to(jnp.arange(GRID_W)[None, :], (rows, GRID_W)).reshape(-1)
    freqs = ROPE_BASE ** (-jnp.arange(0, ROPE_AXIS_DIM, 2, dtype=jnp.float32) / ROPE_AXIS_DIM)
    ang = jnp.stack([row.astype(jnp.float32)[:, None] * freqs,
                     col.astype(jnp.float32)[:, None] * freqs], axis=1)
    return jnp.cos(ang), jnp.sin(ang)


def apply_axial_rope(x, cos, sin):
    xr = x.astype(jnp.float32).reshape(*x.shape[:-1], 2, 2, ROPE_AXIS_DIM // 2)
    x1, x2 = xr[..., 0, :], xr[..., 1, :]
    c = cos[None, :, None]
    s = sin[None, :, None]
    out = jnp.stack([x1 * c - x2 * s, x1 * s + x2 * c], axis=-2)
    return out.reshape(x.shape).astype(x.dtype)


def attend(qg, k, v):
    s = jnp.einsum('bqkgd,bskd->bkgqs', qg, k, preferred_element_type=jnp.float32) * (HEAD_DIM ** -0.5)
    p = jax.nn.softmax(s, axis=-1).astype(v.dtype)
    return jnp.einsum('bkgqs,bskd->bqkgd', p, v)


def latent_attention(q, k_all, v_all):
    b, n = q.shape[:2]
    nblk = n // Q_BLOCK
    qb = q.reshape(b, nblk, Q_BLOCK, N_KV_HEADS, Q_GROUP, HEAD_DIM).transpose(1, 0, 2, 3, 4, 5)
    o = lax.map(lambda qblk: attend(qblk, k_all, v_all), qb)
    return o.transpose(1, 0, 2, 3, 4, 5).reshape(b, n, ATTN_W)


def short_conv3(u, w):
    up = jnp.pad(u, ((0, 0), (1, 1), (0, 0)))
    return up[:, :-2] * w[0] + up[:, 1:-1] * w[1] + up[:, 2:] * w[2]


def split_mix(z):
    cuts = [ATTN_W, ATTN_W + KV_W, ATTN_W + 2 * KV_W,
            ATTN_W + 2 * KV_W + CONV_W, ATTN_W + 2 * KV_W + 2 * CONV_W]
    return jnp.split(z, cuts, axis=-1)


def attn_conv_mixer(a_lat, a_ctx, w_in, q_g, k_g, conv_w, w_out, rope_cos, rope_sin, ctx_live):
    b, n = a_lat.shape[:2]
    nc = a_ctx.shape[1]
    q_l, k_l, v_l, gb_l, gc_l, u_l = split_mix(a_lat @ w_in)
    q_c, k_c, v_c, gb_c, gc_c, u_c = split_mix(a_ctx @ w_in)
    q_l = apply_axial_rope(rms_norm(q_l.reshape(b, n, N_HEADS, HEAD_DIM), q_g), rope_cos, rope_sin)
    k_l = apply_axial_rope(rms_norm(k_l.reshape(b, n, N_KV_HEADS, HEAD_DIM), k_g), rope_cos, rope_sin)
    k_c = rms_norm(k_c.reshape(b, nc, N_KV_HEADS, HEAD_DIM), k_g)
    v_c = v_c.reshape(b, nc, N_KV_HEADS, HEAD_DIM)
    k_all = jnp.concatenate([k_c, k_l], axis=1)
    v_all = jnp.concatenate([v_c, v_l.reshape(b, n, N_KV_HEADS, HEAD_DIM)], axis=1)
    attn_l = latent_attention(q_l, k_all, v_all)
    conv_l = gb_l * short_conv3(gc_l * u_l, conv_w)
    y_lat = jnp.concatenate([attn_l, conv_l], axis=-1) @ w_out
    if not ctx_live:
        return y_lat, None
    q_c = rms_norm(q_c.reshape(b, nc, N_HEADS, HEAD_DIM), q_g)
    attn_c = attend(q_c.reshape(b, nc, N_KV_HEADS, Q_GROUP, HEAD_DIM), k_c, v_c).reshape(b, nc, ATTN_W)
    conv_c = gb_c * short_conv3(gc_c * u_c, conv_w)
    y_ctx = jnp.concatenate([attn_c, conv_c], axis=-1) @ w_out
    return y_lat, y_ctx


def multiscale_pool(h, pool_w, pool_scale):
    b, n, d = h.shape
    hf = h.astype(jnp.float32)
    cs = jnp.concatenate([jnp.zeros((b, 1, d), jnp.float32), jnp.cumsum(hf, axis=1)], axis=1)
    t = jnp.arange(n)
    outs = []
    for gi, w in enumerate(POOL_WINDOWS):
        lo = jnp.clip(t - w // 2, 0, n)
        hi = jnp.clip(t + w - w // 2, 0, n)
        sl = slice(gi * POOL_GROUP_W, (gi + 1) * POOL_GROUP_W)
        csg = cs[..., sl]
        win_sum = jnp.take(csg, hi, axis=1) - jnp.take(csg, lo, axis=1)
        cnt = (hi - lo).astype(jnp.float32)[None, :, None]
        outs.append(win_sum / cnt - hf[..., sl])
    p = jnp.stack(outs, axis=2).astype(h.dtype)
    y = jnp.einsum('bngc,gce->bnge', p, pool_w).reshape(b, n, d)
    return y * pool_scale


def swiglu(h, wg, wu, wd):
    return (jax.nn.silu(h @ wg) * (h @ wu)) @ wd


def moe_top2(h, router_w, router_b, wg, wu, wd):
    logits = (h @ router_w).astype(jnp.float32) + router_b.astype(jnp.float32)
    top_v, top_i = lax.top_k(logits, TOP_K)
    top_p = jax.nn.softmax(top_v, axis=-1)
    gates = jnp.sum(jax.nn.one_hot(top_i, N_EXPERTS, dtype=jnp.float32) * top_p[..., None], axis=-2)
    out = jnp.zeros_like(h)
    for e in range(N_EXPERTS):
        out = out + gates[..., e:e + 1].astype(h.dtype) * swiglu(h, wg[e], wu[e], wd[e])
    return out


def setup_inputs(seed: int = 0) -> dict:
    key = jax.random.key(seed)
    ks = jax.random.split(key, 24)
    f32 = jnp.float32

    def nrm(k, shape, scale):
        return jax.random.normal(k, shape, f32) * scale

    return {
        "x": nrm(ks[0], (BATCH, SEQ, D_MODEL), 1.0),
        "c": nrm(ks[1], (BATCH, D_MODEL), 1.0),
        "ctx": nrm(ks[2], (BATCH, CTX_LEN, D_MODEL), 1.0),
        "c_ctx": nrm(ks[3], (D_MODEL,), 1.0),
        "w_mod": nrm(ks[4], (DEPTH, D_MODEL, N_MOD * D_MODEL), 0.5 * D_MODEL ** -0.5),
        "b_mod": nrm(ks[5], (DEPTH, N_MOD * D_MODEL), 0.02),
        "norm_g": 1.0 + nrm(ks[6], (DEPTH, 2, D_MODEL), 0.05),
        "final_norm_g": 1.0 + nrm(ks[7], (D_MODEL,), 0.05),
        "w_mix_in": nrm(ks[8], (N_EVEN, D_MODEL, MIX_IN_W), D_MODEL ** -0.5),
        "q_norm_g": 1.0 + nrm(ks[9], (N_EVEN, HEAD_DIM), 0.05),
        "k_norm_g": 1.0 + nrm(ks[10], (N_EVEN, HEAD_DIM), 0.05),
        "conv_w": nrm(ks[11], (N_EVEN, 3, CONV_W), 3 ** -0.5),
        "w_mix_out": nrm(ks[12], (N_EVEN, MIX_OUT_IN, D_MODEL), MIX_OUT_IN ** -0.5),
        "ffn_w_gate": nrm(ks[13], (N_EVEN, D_MODEL, D_FF), D_MODEL ** -0.5),
        "ffn_w_up": nrm(ks[14], (N_EVEN, D_MODEL, D_FF), D_MODEL ** -0.5),
        "ffn_w_down": nrm(ks[15], (N_EVEN, D_FF, D_MODEL), D_FF ** -0.5),
        "pool_w": nrm(ks[16], (N_ODD, N_POOL_GROUPS, POOL_GROUP_W, POOL_GROUP_W), POOL_GROUP_W ** -0.5),
        "pool_scale": 1.0 + nrm(ks[17], (N_ODD, D_MODEL), 0.05),
        "router_w": nrm(ks[18], (N_ODD, D_MODEL, N_EXPERTS), D_MODEL ** -0.5),
        "router_b": nrm(ks[19], (N_ODD, N_EXPERTS), 0.01),
        "exp_w_gate": nrm(ks[20], (N_ODD, N_EXPERTS, D_MODEL, D_FF_EXPERT), D_MODEL ** -0.5),
        "exp_w_up": nrm(ks[21], (N_ODD, N_EXPERTS, D_MODEL, D_FF_EXPERT), D_MODEL ** -0.5),
        "exp_w_down": nrm(ks[22], (N_ODD, N_EXPERTS, D_FF_EXPERT, D_MODEL), D_FF_EXPERT ** -0.5),
    }


def reference(x, c, ctx, c_ctx, w_mod, b_mod, norm_g, final_norm_g, w_mix_in, q_norm_g, k_norm_g,
              conv_w, w_mix_out, ffn_w_gate, ffn_w_up, ffn_w_down, pool_w, pool_scale,
              router_w, router_b, exp_w_gate, exp_w_up, exp_w_down):
    n = x.shape[1]
    rope_cos, rope_sin = axial_rope_tables(n)
    x_lat, x_ctx = x, ctx
    for i in range(DEPTH):
        ctx_live = i < DEPTH - 1
        is_even = (i % 2) == 0
        j = i // 2
        sh1, sc1, g1, sh2, sc2, g2 = [m[:, None, :] for m in adaln(c, w_mod[i], b_mod[i])]
        a_lat = modulate(rms_norm(x_lat, norm_g[i, 0]), sh1, sc1)
        need_ctx_in = ctx_live or is_even
        if need_ctx_in:
            csh1, csc1, cg1, csh2, csc2, cg2 = adaln(c_ctx, w_mod[i], b_mod[i])
            a_ctx = modulate(rms_norm(x_ctx, norm_g[i, 0]), csh1, csc1)
        if is_even:
            y_lat, y_ctx = attn_conv_mixer(a_lat, a_ctx, w_mix_in[j], q_norm_g[j], k_norm_g[j], conv_w[j],
                                           w_mix_out[j], rope_cos, rope_sin, ctx_live)
        else:
            y_lat = multiscale_pool(a_lat, pool_w[j], pool_scale[j])
            y_ctx = multiscale_pool(a_ctx, pool_w[j], pool_scale[j]) if ctx_live else None
        x_lat = x_lat + g1 * y_lat
        f_lat = modulate(rms_norm(x_lat, norm_g[i, 1]), sh2, sc2)
        if ctx_live:
            x_ctx = x_ctx + cg1 * y_ctx
            f_ctx = modulate(rms_norm(x_ctx, norm_g[i, 1]), csh2, csc2)
        if is_even:
            x_lat = x_lat + g2 * swiglu(f_lat, ffn_w_gate[j], ffn_w_up[j], ffn_w_down[j])
            if ctx_live:
                x_ctx = x_ctx + cg2 * swiglu(f_ctx, ffn_w_gate[j], ffn_w_up[j], ffn_w_down[j])
        else:
            x_lat = x_lat + g2 * moe_top2(f_lat, router_w[j], router_b[j], exp_w_gate[j], exp_w_up[j], exp_w_down[j])
            if ctx_live:
                x_ctx = x_ctx + cg2 * moe_top2(f_ctx, router_w[j], router_b[j], exp_w_gate[j], exp_w_up[j], exp_w_down[j])
    return rms_norm(x_lat, final_norm_g)
```

```cpp
#define MK_PER_PHASE 0
#include <hip/hip_runtime.h>
#include <hip/hip_bf16.h>
#include <cstdio>
#include <cstdint>
#include <cmath>
namespace pg8 {
#define PG8_LAS __attribute__((address_space(3)))
typedef unsigned short bf16_t;
typedef short bf16x8 __attribute__((ext_vector_type(8)));
typedef float f32x4 __attribute__((ext_vector_type(4)));
typedef unsigned u32x4 __attribute__((ext_vector_type(4)));
constexpr int BM = 256, BK = 64, HALF = 128, HTB = HALF * BK * 2  , STAGE_BYTES = 8 * HTB, NXCD = 8, WGM = 8;

__host__ __device__ __forceinline__ int lds_byte(int r, int c) { const int st = (r >> 4) * 2 + (c >> 5), rr = r & 15, cc = c & 31, ob = rr * 64 + cc * 2; return st * 1024 + (ob ^ (((ob >> 9) & 1) << 5)); }
__host__ __device__ __forceinline__ void stage_rc(int b, int& R, int& C) { const int st = b / 1024, sb = b % 1024, swz = sb ^ (((sb >> 9) & 1) << 5); R = (st >> 1) * 16 + swz / 64; C = (st & 1) * 32 + (swz % 64) / 2; }
__host__ __device__ __forceinline__ int perm32(int rho) { const int n = rho >> 4, i = rho & 15; return 8 * (i >> 2) + 4 * n + (i & 3); }

struct Unit { int pm, pn, e, om; };
struct Gemm { const bf16_t* A; const bf16_t* Bt; int K, lda, ldb; size_t a_pn_bytes, b_e_bytes; };

__host__ __device__ __forceinline__ void tile_map(int L, int nM, int nN, int& pm, int& pn) {
    const int nwg = nM * nN; int wgid = L; { const int q = nwg / NXCD, r = nwg % NXCD, xcd = wgid % NXCD, off = wgid / NXCD; wgid = (xcd < r ? xcd * (q + 1) : r * (q + 1) + (xcd - r) * q) + off; }
    const int nig = WGM * nN, gid = wgid / nig, fm = gid * WGM, gsz = (nM - fm) < WGM ? (nM - fm) : WGM;
    pm = fm + ((wgid % nig) % gsz); pn = (wgid % nig) / gsz;
}

__device__ __forceinline__ unsigned cvt_pk_bf16(float lo, float hi) { unsigned r; asm volatile("v_cvt_pk_bf16_f32 %0, %1, %2" : "=v"(r) : "v"(lo), "v"(hi)); return r; }

struct EpiBf16 {
    static constexpr bool PERM = true, AFTER_DRAIN = false;
    bf16_t* O; int ldc;
    __device__ __forceinline__ void operator()(const f32x4 (&acc)[2][2][4][2], const Unit& u, int wr, int wc, int fr, int fq) const {
        const int row0 = u.om * BM + wr * 64 + fr; const int col0 = u.pn * BM + wc * 32 + 8 * fq;
#pragma unroll
        for (int ai = 0; ai < 2; ++ai)
#pragma unroll
            for (int m = 0; m < 4; ++m) { bf16_t* rowp = O + (size_t)(row0 + ai * HALF + m * 16) * ldc + col0;
#pragma unroll
                for (int bj = 0; bj < 2; ++bj) { const f32x4 v0 = acc[ai][bj][m][0], v1 = acc[ai][bj][m][1];
                    u32x4 w; w.x = cvt_pk_bf16(v0[0], v0[1]); w.y = cvt_pk_bf16(v0[2], v0[3]); w.z = cvt_pk_bf16(v1[0], v1[1]); w.w = cvt_pk_bf16(v1[2], v1[3]);
                    *(u32x4*)(rowp + bj * HALF) = w; } }
    }
};
struct EpiSwiGLU {
    static constexpr bool PERM = true, AFTER_DRAIN = false;
    bf16_t* O; int ldc;
    __device__ __forceinline__ static float silu_mul(float g, float u) { return g * u * __builtin_amdgcn_rcpf(1.0f + __builtin_amdgcn_exp2f(g * -1.4426950408889634f)); }
    __device__ __forceinline__ void operator()(const f32x4 (&acc)[2][2][4][2], const Unit& u, int wr, int wc, int fr, int fq) const {
        const int row0 = u.om * BM + wr * 64 + fr; const int col0 = u.pn * HALF + wc * 32 + 8 * fq;
#pragma unroll
        for (int ai = 0; ai < 2; ++ai)
#pragma unroll
            for (int m = 0; m < 4; ++m) { bf16_t* rowp = O + (size_t)(row0 + ai * HALF + m * 16) * ldc + col0;
                const f32x4 g0 = acc[ai][0][m][0], g1 = acc[ai][0][m][1], u0 = acc[ai][1][m][0], u1 = acc[ai][1][m][1];
                u32x4 w; w.x = cvt_pk_bf16(silu_mul(g0[0], u0[0]), silu_mul(g0[1], u0[1])); w.y = cvt_pk_bf16(silu_mul(g0[2], u0[2]), silu_mul(g0[3], u0[3]));
                w.z = cvt_pk_bf16(silu_mul(g1[0], u1[0]), silu_mul(g1[1], u1[1])); w.w = cvt_pk_bf16(silu_mul(g1[2], u1[2]), silu_mul(g1[3], u1[3]));
                *(u32x4*)rowp = w; }
    }
};
struct EpiRes {
    static constexpr bool PERM = false, AFTER_DRAIN = false;
    const float* base; float* out; const float* gate; int gate_bstride; const float* cscale;
    __device__ __forceinline__ void operator()(const f32x4 (&acc)[2][2][4][2], const Unit& u, int wr, int wc, int fr, int fq) const {
        const int row0 = u.om * BM + wr * 64 + fr, col0 = u.pn * BM + wc * 32 + 4 * fq; const int b = u.om >> 5;
        f32x4 gv[2][2];
#pragma unroll
        for (int bj = 0; bj < 2; ++bj)
#pragma unroll
            for (int n = 0; n < 2; ++n) { gv[bj][n] = *(const f32x4*)(gate + (size_t)b * gate_bstride + col0 + bj * HALF + n * 16); if (cscale) gv[bj][n] = gv[bj][n] * *(const f32x4*)(cscale + col0 + bj * HALF + n * 16); }
#pragma unroll
        for (int ai = 0; ai < 2; ++ai)
#pragma unroll
            for (int m = 0; m < 4; ++m) { const size_t off = (size_t)(row0 + ai * HALF + m * 16) * 1024 + col0;
#pragma unroll
                for (int bj = 0; bj < 2; ++bj)
#pragma unroll
                    for (int n = 0; n < 2; ++n) { const f32x4 bs = *(const f32x4*)(base + off + bj * HALF + n * 16); *(f32x4*)(out + off + bj * HALF + n * 16) = bs + gv[bj][n] * acc[ai][bj][m][n]; }
                if (m & 1) asm volatile("" ::: "memory"); }
    }
};
template <class Epi, class Sched, bool ALIGN_EPI = false, bool SP2 = false>
__device__ __forceinline__ void gemm_phase(PG8_LAS unsigned char* lds, const Gemm g, const Sched& S, const Epi& E) {
    const int tid = threadIdx.x, wid = __builtin_amdgcn_readfirstlane(tid >> 6), lane = tid & 63, wr = wid >> 2, wc = wid & 3, fr = lane & 15, fq = lane >> 4;
    const int K = g.K, nt = K / BK;
    unsigned voffA[2], voffB[2];
#pragma unroll
    for (int i = 0; i < 2; ++i) { int R, C; stage_rc(tid * 16 + i * 8192, R, C); const int Rb = Epi::PERM ? ((R & ~31) + perm32(R & 31)) : R;
        voffA[i] = (unsigned)(R * g.lda + C) * 2u; voffB[i] = (unsigned)(Rb * g.ldb + C) * 2u; }
    const size_t kstep = (size_t)(BK * 2);
    const size_t hstepA = (size_t)HALF * g.lda * 2, hstepB = (size_t)HALF * g.ldb * 2;
    const size_t tstepA = 2 * hstepA, tstepB = 2 * hstepB;
    const unsigned ldsw = (unsigned)wid * 1024u;
    const int aoff = lds_byte(wr * 64 + fr, fq * 8), boff = lds_byte(wc * 32 + fr, fq * 8);
#define PG8_SA(b, h) (((b) * 2 + (h)) * HTB)
#define PG8_SB(b, h) ((4 + (b) * 2 + (h)) * HTB)
#define PG8_STAGE(bufoff, gbase, voff) do { _Pragma("unroll") for (int _i = 0; _i < 2; ++_i) \
        __builtin_amdgcn_global_load_lds((const unsigned*)((const char*)(gbase) + (voff)[_i]), (PG8_LAS unsigned*)(lds + (bufoff) + ldsw + _i * 8192), 16, 0, 0); } while (0)
#define PG8_LDA(dst, b, h) do { _Pragma("unroll") for (int m = 0; m < 4; ++m) _Pragma("unroll") for (int k = 0; k < 2; ++k) dst[m][k] = *(const PG8_LAS bf16x8*)(lds + PG8_SA(b, h) + aoff + m * 2048 + k * 1024); } while (0)
#define PG8_LDB(dst, b, h) do { _Pragma("unroll") for (int n = 0; n < 2; ++n) _Pragma("unroll") for (int k = 0; k < 2; ++k) dst[n][k] = *(const PG8_LAS bf16x8*)(lds + PG8_SB(b, h) + boff + n * 2048 + k * 1024); } while (0)
#define PG8_MMA(ai, bj, At, Bt) do { __builtin_amdgcn_s_setprio(1); _Pragma("unroll") for (int m = 0; m < 4; ++m) _Pragma("unroll") for (int n = 0; n < 2; ++n) _Pragma("unroll") for (int k = 0; k < 2; ++k) \
        acc[ai][bj][m][n] = __builtin_amdgcn_mfma_f32_16x16x32_bf16(Bt[n][k], At[m][k], acc[ai][bj][m][n], 0, 0, 0); __builtin_amdgcn_s_setprio(0); } while (0)
#define PG8_WAIT_V(n) asm volatile("s_waitcnt vmcnt(" #n ")" ::: "memory")
#define PG8_WAIT_L(n) asm volatile("s_waitcnt lgkmcnt(" #n ")" ::: "memory")
#define PG8_BAR __builtin_amdgcn_s_barrier()
#define PG8_SCHED __builtin_amdgcn_sched_barrier(0)
    Unit cur, nxt; int ui = 0;
    if (!S.next(0, cur)) return;
    f32x4 acc[2][2][4][2];
#pragma unroll
    for (int a = 0; a < 2; ++a)
#pragma unroll
        for (int b = 0; b < 2; ++b)
#pragma unroll
            for (int m = 0; m < 4; ++m)
#pragma unroll
                for (int n = 0; n < 2; ++n) acc[a][b][m][n] = (f32x4){0.f, 0.f, 0.f, 0.f};
    bf16x8 At[4][2], B0[2][2], B1[2][2];
    const char* cA = (const char*)g.A + (size_t)cur.pm * tstepA + (size_t)cur.pn * g.a_pn_bytes; const char* cB = (const char*)g.Bt + (size_t)cur.pn * tstepB + (size_t)cur.e * g.b_e_bytes;
    S.a_ready(cur);
    if constexpr (SP2) {
        PG8_STAGE(PG8_SB(0, 0), cB, voffB); PG8_STAGE(PG8_SB(0, 1), cB + hstepB, voffB); PG8_STAGE(PG8_SA(0, 0), cA, voffA); PG8_STAGE(PG8_SA(0, 1), cA + hstepA, voffA);
        if (wr == 1) PG8_BAR;
        PG8_WAIT_V(2); PG8_BAR;
        PG8_STAGE(PG8_SB(1, 0), cB + kstep, voffB); PG8_STAGE(PG8_SA(1, 0), cA + kstep, voffA); PG8_STAGE(PG8_SB(1, 1), cB + hstepB + kstep, voffB);
        PG8_WAIT_V(6); PG8_BAR;
    } else {
        PG8_STAGE(PG8_SB(0, 0), cB, voffB); PG8_STAGE(PG8_SA(0, 0), cA, voffA); PG8_STAGE(PG8_SB(0, 1), cB + hstepB, voffB); PG8_STAGE(PG8_SA(0, 1), cA + hstepA, voffA);
        if (wr == 1) PG8_BAR;
        PG8_WAIT_V(4); PG8_BAR;
        PG8_STAGE(PG8_SB(1, 0), cB + kstep, voffB); PG8_STAGE(PG8_SA(1, 0), cA + kstep, voffA); PG8_STAGE(PG8_SB(1, 1), cB + hstepB + kstep, voffB);
        PG8_WAIT_V(6); PG8_BAR;
    }
    for (;;) {
        const bool has_next = S.next(ui + 1, nxt);
        const char* nA = has_next ? (const char*)g.A + (size_t)nxt.pm * tstepA + (size_t)nxt.pn * g.a_pn_bytes : cA; const char* nB = has_next ? (const char*)g.Bt + (size_t)nxt.pn * tstepB + (size_t)nxt.e * g.b_e_bytes : cB;
        for (int t = 0; t < nt; t += 2) {
            const bool last = (t == nt - 2);
            const char* a1 = cA + (size_t)(t + 1) * kstep;
            const char* a2 = last ? nA : cA + (size_t)(t + 2) * kstep; const char* b2 = last ? nB : cB + (size_t)(t + 2) * kstep;
            const char* a3 = a2 + kstep; const char* b3 = b2 + kstep;
            if (last && has_next) S.a_ready(nxt);
            if constexpr (SP2) {
            PG8_LDB(B0, 0, 0); PG8_LDB(B1, 0, 1); PG8_SCHED; PG8_LDA(At, 0, 0); PG8_STAGE(PG8_SA(1, 1), a1 + hstepA, voffA);
            PG8_WAIT_V(8); PG8_WAIT_L(0); PG8_BAR; PG8_MMA(0, 0, At, B0); PG8_MMA(0, 1, At, B1); PG8_BAR; PG8_SCHED;
            PG8_LDA(At, 0, 1); PG8_STAGE(PG8_SB(0, 0), b2, voffB); PG8_STAGE(PG8_SB(0, 1), b2 + hstepB, voffB); PG8_STAGE(PG8_SA(0, 0), a2, voffA);
            PG8_WAIT_V(8); PG8_WAIT_L(0); PG8_BAR; PG8_MMA(1, 0, At, B0); PG8_MMA(1, 1, At, B1); PG8_BAR; PG8_SCHED;
            PG8_LDB(B0, 1, 0); PG8_LDB(B1, 1, 1); PG8_SCHED; PG8_LDA(At, 1, 0); PG8_STAGE(PG8_SA(0, 1), a2 + hstepA, voffA);
            PG8_WAIT_V(8); PG8_WAIT_L(0); PG8_BAR; PG8_MMA(0, 0, At, B0); PG8_MMA(0, 1, At, B1); PG8_BAR; PG8_SCHED;
            PG8_LDA(At, 1, 1); PG8_STAGE(PG8_SB(1, 0), b3, voffB); PG8_STAGE(PG8_SB(1, 1), b3 + hstepB, voffB); PG8_STAGE(PG8_SA(1, 0), a3, voffA);
            PG8_WAIT_V(8); PG8_WAIT_L(0); PG8_BAR; PG8_MMA(1, 0, At, B0); PG8_MMA(1, 1, At, B1); PG8_BAR; PG8_SCHED;
            } else {
            PG8_LDB(B0, 0, 0); PG8_SCHED; PG8_LDA(At, 0, 0); PG8_STAGE(PG8_SA(1, 1), a1 + hstepA, voffA);
            PG8_WAIT_L(8); PG8_BAR; PG8_WAIT_L(0); PG8_MMA(0, 0, At, B0); PG8_BAR; PG8_SCHED;
            PG8_LDB(B1, 0, 1); PG8_STAGE(PG8_SB(0, 0), b2, voffB);
            PG8_BAR; PG8_WAIT_L(0); PG8_MMA(0, 1, At, B1); PG8_BAR;
            PG8_LDA(At, 0, 1); PG8_STAGE(PG8_SA(0, 0), a2, voffA);
            PG8_BAR; PG8_WAIT_L(0); PG8_MMA(1, 0, At, B0); PG8_BAR; PG8_SCHED;
            PG8_STAGE(PG8_SB(0, 1), b2 + hstepB, voffB);
            PG8_WAIT_V(6); PG8_BAR; PG8_MMA(1, 1, At, B1); PG8_BAR;
            PG8_LDB(B0, 1, 0); PG8_SCHED; PG8_LDA(At, 1, 0); PG8_STAGE(PG8_SA(0, 1), a2 + hstepA, voffA);
            PG8_WAIT_L(8); PG8_BAR; PG8_WAIT_L(0); PG8_MMA(0, 0, At, B0); PG8_BAR; PG8_SCHED;
            PG8_LDB(B1, 1, 1); PG8_STAGE(PG8_SB(1, 0), b3, voffB);
            PG8_BAR; PG8_WAIT_L(0); PG8_MMA(0, 1, At, B1); PG8_BAR;
            PG8_LDA(At, 1, 1); PG8_STAGE(PG8_SA(1, 0), a3, voffA);
            PG8_BAR; PG8_WAIT_L(0); PG8_MMA(1, 0, At, B0); PG8_BAR; PG8_SCHED;
            PG8_STAGE(PG8_SB(1, 1), b3 + hstepB, voffB);
            PG8_WAIT_V(6); PG8_BAR; PG8_MMA(1, 1, At, B1); PG8_BAR;
            }
        }
        if constexpr (ALIGN_EPI) { if (wr == 0) PG8_BAR; }
        if constexpr (!Epi::AFTER_DRAIN) { E(acc, cur, wr, wc, fr, fq); S.done(cur); }
        if (!has_next) break;
#pragma unroll
        for (int a = 0; a < 2; ++a)
#pragma unroll
            for (int b = 0; b < 2; ++b)
#pragma unroll
                for (int m = 0; m < 4; ++m)
#pragma unroll
                    for (int n = 0; n < 2; ++n) acc[a][b][m][n] = (f32x4){0.f, 0.f, 0.f, 0.f};
        cur = nxt; cA = nA; cB = nB; ++ui;
        if constexpr (ALIGN_EPI) { if (wr == 1) PG8_BAR; }
    }
    PG8_WAIT_V(0);
    if constexpr (!ALIGN_EPI) { if (wr == 0) PG8_BAR; }
    PG8_BAR;
    if constexpr (Epi::AFTER_DRAIN) { E.fused(acc, cur, wr, wc, fr, fq, lds, wid, lane); S.done(cur); }
#undef PG8_SA
#undef PG8_SB
#undef PG8_STAGE
#undef PG8_LDA
#undef PG8_LDB
#undef PG8_MMA
#undef PG8_WAIT_V
#undef PG8_WAIT_L
#undef PG8_BAR
#undef PG8_SCHED
}
}
#include <hip/hip_bf16.h>
#include <cmath>
namespace attn_body {
using bf16=__hip_bfloat16;
using bf16x8=__attribute__((ext_vector_type(8)))short;
using s16x4=__attribute__((ext_vector_type(4)))short;
using f32x16=__attribute__((ext_vector_type(16)))float;
using u32x4=__attribute__((ext_vector_type(4)))unsigned;
constexpr int D=64,DM=2304,SKV=8448,SCTX=256;
constexpr int NW=8,QBLK=32,QB=QBLK*NW,KVBLK=64,NQB=32;
constexpr int ATTN_PITCH=DM, ATTN_UNIT_ROWS=QB;
__device__ __forceinline__ int crow(int r,int hi){return (r&3)+8*(r>>2)+4*hi;}
#define SBAR() __builtin_amdgcn_sched_barrier(0)
__device__ __forceinline__ void cmask(f32x16&p0,f32x16&p1,int jb,int qrel,int hi){
  const float NEG=-INFINITY; int kb=64*jb+4*hi;
  #pragma unroll
  for(int r=0;r<16;++r){int kv=kb+(r&3)+8*(r>>2); if(kv>qrel)p0[r]=NEG; if(kv+32>qrel)p1[r]=NEG;}
}

constexpr int NSLOT=3, SLOTB=8192;
constexpr int LDS_K=0, LDS_V=NSLOT*SLOTB, LDS_WS=2*NSLOT*SLOTB, LDS_OST=LDS_WS+NW*64*4, LDS_BYTES=LDS_OST+NW*4096;
constexpr float C2=0.125f*1.4426950408889634f;
__device__ __forceinline__ void glds16(const void*gsrc,unsigned lds_dst){unsigned keep;
  asm volatile("s_mov_b32 %0, m0\n\ts_mov_b32 m0, %2\n\ts_nop 0\n\tglobal_load_lds_dwordx4 %1, off\n\ts_mov_b32 m0, %0":"=&s"(keep):"v"(gsrc),"s"(lds_dst):"memory");}
__device__ __forceinline__ float max3f(float a,float b,float c){float r;asm("v_max3_f32 %0, %1, %2, %3":"=v"(r):"v"(a),"v"(b),"v"(c));return r;}
__device__ __forceinline__ float max2f(float a,float b){float r;asm("v_max_f32_e32 %0, %1, %2":"=v"(r):"v"(a),"v"(b));return r;}
__device__ __forceinline__ float fadd_s(float a,float b){float r;asm("v_add_f32_e32 %0, %1, %2":"=v"(r):"v"(a),"v"(b));return r;}
__device__ __forceinline__ float fsub_s(float a,float b){float r;asm("v_sub_f32_e32 %0, %1, %2":"=v"(r):"v"(a),"v"(b));return r;}
typedef float f32x2_t __attribute__((ext_vector_type(2))); typedef __bf16 bf16x2_t __attribute__((ext_vector_type(2)));
__device__ __forceinline__ unsigned cvtpk_s(float lo,float hi){f32x2_t v={lo,hi};bf16x2_t b=__builtin_convertvector(v,bf16x2_t);return __builtin_bit_cast(unsigned,b);}
#define WAIT_BAR(N) asm volatile("s_waitcnt vmcnt(" #N ") lgkmcnt(0)\n\ts_barrier":::"memory")

__device__ __forceinline__ void qkt(f32x16&p0,f32x16&p1,const char*Kslot,const bf16x8*qr,const f32x16&negm,int r32,int hi){
  const char*kb=Kslot+hi*1024+r32*16;
  #pragma unroll
  for(int d0=0;d0<4;++d0){
    const bf16x8 b0=*reinterpret_cast<const bf16x8*>(kb+d0*2048);
    const bf16x8 b1=*reinterpret_cast<const bf16x8*>(kb+d0*2048+512);
    if(d0==0){p0=__builtin_amdgcn_mfma_f32_32x32x16_bf16(b0,qr[0],negm,0,0,0);p1=__builtin_amdgcn_mfma_f32_32x32x16_bf16(b1,qr[0],negm,0,0,0);}
    else{p0=__builtin_amdgcn_mfma_f32_32x32x16_bf16(b0,qr[d0],p0,0,0,0);p1=__builtin_amdgcn_mfma_f32_32x32x16_bf16(b1,qr[d0],p1,0,0,0);}}
}
typedef __attribute__((address_space(3))) const char* lds_cptr;
typedef short v4i16_t __attribute__((ext_vector_type(4)));
__device__ __forceinline__ void kload8(bf16x8*kf,lds_cptr kp){
  kf[0]=*(const __attribute__((address_space(3))) bf16x8*)(kp);      kf[1]=*(const __attribute__((address_space(3))) bf16x8*)(kp+512);
  kf[2]=*(const __attribute__((address_space(3))) bf16x8*)(kp+2048); kf[3]=*(const __attribute__((address_space(3))) bf16x8*)(kp+2560);
  kf[4]=*(const __attribute__((address_space(3))) bf16x8*)(kp+4096); kf[5]=*(const __attribute__((address_space(3))) bf16x8*)(kp+4608);
  kf[6]=*(const __attribute__((address_space(3))) bf16x8*)(kp+6144); kf[7]=*(const __attribute__((address_space(3))) bf16x8*)(kp+6656);
}
__device__ __forceinline__ void kload2(bf16x8*kf,lds_cptr kp,int j){ kf[2*j]=*(const __attribute__((address_space(3))) bf16x8*)(kp+j*2048); kf[2*j+1]=*(const __attribute__((address_space(3))) bf16x8*)(kp+j*2048+512); }
__device__ __forceinline__ s16x4 vtr(lds_cptr p){ return __builtin_bit_cast(s16x4,__builtin_amdgcn_ds_read_tr16_b64_v4i16((__attribute__((address_space(3))) v4i16_t*)p)); }
__device__ __forceinline__ float rowmax(const f32x16&p0,const f32x16&p1){
  float a=max3f(p0[0],p0[1],p1[0]),b=max3f(p0[2],p0[3],p1[1]);a=max3f(a,p1[2],p1[3]);
  #pragma unroll
  for(int r=4;r<16;r+=4){a=max3f(a,p0[r],p0[r+1]);b=max3f(b,p0[r+2],p0[r+3]);a=max3f(a,p1[r],p1[r+1]);b=max3f(b,p1[r+2],p1[r+3]);}
  const float m=max2f(a,b);
  auto rr=__builtin_amdgcn_permlane32_swap(__float_as_uint(m),__float_as_uint(m),false,false);
  return max2f(__uint_as_float(rr[0]),__uint_as_float(rr[1]));
}
__device__ __forceinline__ void pv(f32x16*o,int vb,bf16x8 pa0,bf16x8 pa1,bf16x8 pa2,bf16x8 pa3){
  #pragma unroll
  for(int d0=0;d0<2;++d0){s16x4 lo[4],hi[4];
    #pragma unroll
    for(int ks=0;ks<4;++ks){
      asm volatile("ds_read_b64_tr_b16 %0,%1 offset:%c2":"=&v"(lo[ks]):"v"(vb),"i"(d0*4096+ks*1024):"memory");
      asm volatile("ds_read_b64_tr_b16 %0,%1 offset:%c2":"=&v"(hi[ks]):"v"(vb),"i"(d0*4096+ks*1024+512):"memory");}
    asm volatile("s_waitcnt lgkmcnt(0)":::"memory");SBAR();
    #define PK(k) (bf16x8){lo[k][0],lo[k][1],lo[k][2],lo[k][3],hi[k][0],hi[k][1],hi[k][2],hi[k][3]}
    o[d0]=__builtin_amdgcn_mfma_f32_32x32x16_bf16(pa0,PK(0),o[d0],0,0,0);
    o[d0]=__builtin_amdgcn_mfma_f32_32x32x16_bf16(pa1,PK(1),o[d0],0,0,0);
    o[d0]=__builtin_amdgcn_mfma_f32_32x32x16_bf16(pa2,PK(2),o[d0],0,0,0);
    o[d0]=__builtin_amdgcn_mfma_f32_32x32x16_bf16(pa3,PK(3),o[d0],0,0,0);
    #undef PK
  }
}

#ifndef ATTN_STORE16
#define ATTN_STORE16(p,v) (*(u32x4*)(p)=(v))
#endif
template<int THRL> __device__ __forceinline__ void attn_unit(int b,int h,int qb,const bf16*Q,const bf16*__restrict__ K,const bf16*__restrict__ V,bf16*O,char*shm){
  const int tid=threadIdx.x,lane=tid&63,r32=lane&31,hi=lane>>5; const int wid=__builtin_amdgcn_readfirstlane(tid>>6);
  const long rowbase=(long)b*SKV; const int q0=SCTX+qb*QB; const int kvh=h>>2;
  const bf16*Qw=Q+(rowbase+q0+wid*QBLK)*DM+h*D;
  const bf16*Kh=K+rowbase*DM+kvh*D,*Vh=V+rowbase*DM+kvh*D;
  const unsigned lds0=(unsigned)(uintptr_t)shm;
  float*wsf=(float*)(shm+LDS_WS)+wid*64;
  const bf16*ksrc=Kh+(long)lane*DM+wid*8;
  const bf16*vsrc=Vh+(long)(16*(wid&3)+(lane>>2))*DM+(wid>>2)*32+(lane&3)*8;
  const unsigned kdst=lds0+LDS_K+wid*1024, vdst=lds0+LDS_V+wid*1024;
  #define DMA_K(t,slot) glds16(ksrc+(long)(t)*KVBLK*DM,(unsigned)__builtin_amdgcn_readfirstlane(kdst+(slot)))
  #define DMA_V(t,slot) glds16(vsrc+(long)(t)*KVBLK*DM,(unsigned)__builtin_amdgcn_readfirstlane(vdst+(slot)))
  const int vb0=(int)(lds0+LDS_V)+((lane>>4)&1)*32+(lane&3)*8+(4*hi+((lane&15)>>2))*64;
  const char*Kbase=shm+LDS_K; bf16x8 kf[8];
  const lds_cptr shm3=(lds_cptr)shm; const lds_cptr kp0=shm3+LDS_K+hi*1024+r32*16; const lds_cptr vp0=shm3+LDS_V+((lane>>4)&1)*32+(lane&3)*8+(4*hi+((lane&15)>>2))*64;
  constexpr int NT=SKV/KVBLK;
  DMA_K(0,0);DMA_V(0,0);DMA_K(1,SLOTB);
  bf16x8 qr[4];
  #pragma unroll
  for(int d0=0;d0<4;++d0)qr[d0]=*reinterpret_cast<const bf16x8*>(&Qw[(long)r32*DM+d0*16+hi*8]);
  float mhat=0.f,l_reg=0.f;f32x16 o[2];o[0]=f32x16{};o[1]=f32x16{};f32x16 negm=f32x16{};asm volatile("":"+v"(negm));
  const int qrel=wid*QBLK+r32;
  #define CMASK(P0,P1,t) do{}while(0)
  bool resc=false;
  #define START(P0,P1) do{ const float rm=rowmax(P0,P1); resc=false; \
    { const float dl=rm; mhat=fadd_s(mhat,dl); \
      _Pragma("unroll") for(int r=0;r<16;++r){P0[r]=fsub_s(P0[r],dl);P1[r]=fsub_s(P1[r],dl);} \
      _Pragma("unroll") for(int r=0;r<16;++r)negm[r]=-mhat; asm volatile("":"+v"(negm)); } \
    _Pragma("unroll") for(int r=0;r<16;++r)P0[r]=__builtin_amdgcn_exp2f(P0[r]); }while(0)
  #define RESC() do{ if(resc){ asm volatile("s_waitcnt lgkmcnt(0)":::"memory"); \
      _Pragma("unroll") for(int d_=0;d_<2;++d_) _Pragma("unroll") for(int r=0;r<16;++r)o[d_][r]*=wsf[crow(r,hi)]; } }while(0)
  f32x16 pA0,pA1,pB0,pB1;
  int sl_prev=0,sl_cur=0,sl_next=SLOTB;
  #define ROT() do{sl_prev=sl_cur;sl_cur=sl_next;sl_next=(sl_next==(NSLOT-1)*SLOTB)?0:sl_next+SLOTB;}while(0)
  DMA_K(2,2*SLOTB);
  WAIT_BAR(3);
  qkt(pA0,pA1,Kbase,qr,negm,r32,hi);asm volatile("s_nop 15\n\ts_nop 7":"+v"(pA0),"+v"(pA1));CMASK(pA0,pA1,0);
  START(pA0,pA1);
  _Pragma("unroll") for(int r=0;r<16;++r)pA1[r]=__builtin_amdgcn_exp2f(pA1[r]);
  WAIT_BAR(0);
  DMA_K(3,0);DMA_V(1,SLOTB);
  ROT();
  kload8(kf,kp0+sl_cur);
  WAIT_BAR(2);
  s16x4 vlo[8],vhi[8]; u32x4 pw0,pw1,pw2,pw3;
  #define PKW(P,B) cvtpk_s(P[B],P[B+1])
  #define PAF(k) __builtin_bit_cast(bf16x8,pw##k)
  #define VFR(i) (bf16x8){vlo[i][0],vlo[i][1],vlo[i][2],vlo[i][3],vhi[i][0],vhi[i][1],vhi[i][2],vhi[i][3]}
  #define PIN(x) asm volatile("":"+v"(x))
  #define MX3(a,b,c) __builtin_fmaxf(__builtin_fmaxf((a),(b)),(c))
  #define GAPA(MF,A0,A1,A2,A3,W0,W1,PW) do{ MF; sacc+=A0; sacc+=A1; sacc+=A2; sacc+=A3; PIN(sacc); W0; W1; PIN(PW); SBAR(); }while(0)
  #define EX(v) __builtin_amdgcn_exp2f(v)
  #define GAPB(MF,X,B) do{ MF; X[B]=EX(X[B]); X[B+1]=EX(X[B+1]); X[B+2]=EX(X[B+2]); X[B+3]=EX(X[B+3]); PIN(X); SBAR(); }while(0)
  #define VRD(i) do{ vlo[i]=vtr(vp_+(((i)>>2)*4096+((i)&3)*1024)); vhi[i]=vtr(vp_+(((i)>>2)*4096+((i)&3)*1024+512)); }while(0)
  #define KRD(G,j) do{ if(G){ kload2(kf,kp0+sl_next,j); SBAR(); } }while(0)
  #define STEP(C0,C1,P0,P1,t,GK,GV,GL) do{ SBAR(); \
    const lds_cptr vp_=vp0+sl_prev; \
    VRD(0); SBAR(); float sacc=(P0[0]+P0[1]); \
    GAPA(C0=__builtin_amdgcn_mfma_f32_32x32x16_bf16(kf[0],qr[0],negm,0,0,0), P0[2],P0[3],P0[4],P0[5],     pw0[0]=PKW(P0,0), pw0[1]=PKW(P0,2), pw0); \
    VRD(4); SBAR(); GAPA(C1=__builtin_amdgcn_mfma_f32_32x32x16_bf16(kf[1],qr[0],negm,0,0,0), P0[6],P0[7],P0[8],P0[9],     pw0[2]=PKW(P0,4), pw0[3]=PKW(P0,6), pw0); \
    VRD(1); SBAR(); GAPA(C0=__builtin_amdgcn_mfma_f32_32x32x16_bf16(kf[2],qr[1],C0,0,0,0),   P0[10],P0[11],P0[12],P0[13], pw1[0]=PKW(P0,8), pw1[1]=PKW(P0,10), pw1); \
    VRD(5); SBAR(); GAPA(C1=__builtin_amdgcn_mfma_f32_32x32x16_bf16(kf[3],qr[1],C1,0,0,0),   P0[14],P0[15],P1[0],P1[1],   pw1[2]=PKW(P0,12),pw1[3]=PKW(P0,14), pw1); \
    VRD(2); SBAR(); GAPA(C0=__builtin_amdgcn_mfma_f32_32x32x16_bf16(kf[4],qr[2],C0,0,0,0),   P1[2],P1[3],P1[4],P1[5],     pw2[0]=PKW(P1,0), pw2[1]=PKW(P1,2), pw2); \
    VRD(6); SBAR(); GAPA(C1=__builtin_amdgcn_mfma_f32_32x32x16_bf16(kf[5],qr[2],C1,0,0,0),   P1[6],P1[7],P1[8],P1[9],     pw2[2]=PKW(P1,4), pw2[3]=PKW(P1,6), pw2); \
    VRD(3); SBAR(); GAPA(C0=__builtin_amdgcn_mfma_f32_32x32x16_bf16(kf[6],qr[3],C0,0,0,0),   P1[10],P1[11],P1[12],P1[13], pw3[0]=PKW(P1,8), pw3[1]=PKW(P1,10), pw3); \
    VRD(7); SBAR(); GAPA(C1=__builtin_amdgcn_mfma_f32_32x32x16_bf16(kf[7],qr[3],C1,0,0,0),   P1[14],P1[15],0.f,0.f,       pw3[2]=PKW(P1,12),pw3[3]=PKW(P1,14), pw3); \
    l_reg+=sacc; \
    if(GK){DMA_K((t)+3,sl_cur);} if(GV){DMA_V((t)+1,sl_next);} \
    CMASK(C0,C1,t); \
    { float a=MX3(C0[0],C0[1],C1[0]),b=MX3(C0[2],C0[3],C1[1]); a=MX3(a,C1[2],C1[3]); \
      _Pragma("unroll") for(int r=4;r<16;r+=4){a=MX3(a,C0[r],C0[r+1]);b=MX3(b,C0[r+2],C0[r+3]);a=MX3(a,C1[r],C1[r+1]);b=MX3(b,C1[r+2],C1[r+3]);} \
      float rm=__builtin_fmaxf(a,b); { auto rr=__builtin_amdgcn_permlane32_swap(__float_as_uint(rm),__float_as_uint(rm),false,false); rm=__builtin_fmaxf(__uint_as_float(rr[0]),__uint_as_float(rr[1])); } \
      resc=false; \
      if(__builtin_expect(__any(rm>(float)THRL),0)){ const float dl=__builtin_fmaxf(rm,0.f); mhat+=dl; \
        _Pragma("unroll") for(int r=0;r<16;++r){C0[r]-=dl;C1[r]-=dl;} \
        _Pragma("unroll") for(int r=0;r<16;++r)negm[r]=-mhat; asm volatile("":"+v"(negm)); \
        const float f=__builtin_amdgcn_exp2f(-dl); l_reg*=f; if(hi==0)wsf[r32]=f; resc=true; } } \
    SBAR(); \
    GAPB(o[0]=__builtin_amdgcn_mfma_f32_32x32x16_bf16(PAF(0),VFR(0),o[0],0,0,0), C0,0); \
    GAPB(o[1]=__builtin_amdgcn_mfma_f32_32x32x16_bf16(PAF(0),VFR(4),o[1],0,0,0), C0,4); \
    KRD(GL,0); GAPB(o[0]=__builtin_amdgcn_mfma_f32_32x32x16_bf16(PAF(1),VFR(1),o[0],0,0,0), C0,8); \
    KRD(GL,1); GAPB(o[1]=__builtin_amdgcn_mfma_f32_32x32x16_bf16(PAF(1),VFR(5),o[1],0,0,0), C0,12); \
    KRD(GL,2); GAPB(o[0]=__builtin_amdgcn_mfma_f32_32x32x16_bf16(PAF(2),VFR(2),o[0],0,0,0), C1,0); \
    KRD(GL,3); GAPB(o[1]=__builtin_amdgcn_mfma_f32_32x32x16_bf16(PAF(2),VFR(6),o[1],0,0,0), C1,4); \
    GAPB(o[0]=__builtin_amdgcn_mfma_f32_32x32x16_bf16(PAF(3),VFR(3),o[0],0,0,0), C1,8); \
    GAPB(o[1]=__builtin_amdgcn_mfma_f32_32x32x16_bf16(PAF(3),VFR(7),o[1],0,0,0), C1,12); \
    }while(0)
  int t=1;
  for(;t+5<NT;t+=2){
    STEP(pB0,pB1,pA0,pA1,t,true,true,true);     WAIT_BAR(2); RESC(); ROT();
    STEP(pA0,pA1,pB0,pB1,t+1,true,true,true);   WAIT_BAR(2); RESC(); ROT();
  }
  #define ENDW(tt) do{ if((tt)+3<NT){WAIT_BAR(2);} else if((tt)+2<NT){WAIT_BAR(1);} else {WAIT_BAR(0);} }while(0)
  for(;t+1<NT;t+=2){
    STEP(pB0,pB1,pA0,pA1,t,(t+3<NT),(t+1<NT),(t+1<NT));       ENDW(t);   RESC(); ROT();
    STEP(pA0,pA1,pB0,pB1,t+1,(t+4<NT),(t+2<NT),(t+2<NT));     ENDW(t+1); RESC(); ROT();
  }
  STEP(pB0,pB1,pA0,pA1,NT-1,false,false,false); RESC();
  { float sacc=pB0[0]+pB0[1]; _Pragma("unroll") for(int r=2;r<16;++r)sacc+=pB0[r]; _Pragma("unroll") for(int r=0;r<16;++r)sacc+=pB1[r]; l_reg+=sacc;
    pw0=(u32x4){PKW(pB0,0),PKW(pB0,2),PKW(pB0,4),PKW(pB0,6)};pw1=(u32x4){PKW(pB0,8),PKW(pB0,10),PKW(pB0,12),PKW(pB0,14)};pw2=(u32x4){PKW(pB1,0),PKW(pB1,2),PKW(pB1,4),PKW(pB1,6)};pw3=(u32x4){PKW(pB1,8),PKW(pB1,10),PKW(pB1,12),PKW(pB1,14)};
    SBAR(); pv(o,vb0+sl_cur,PAF(0),PAF(1),PAF(2),PAF(3)); }
  #undef PKW
  #undef PAF
  #undef VFR
  #undef PIN
  #undef MX3
  #undef GAPA
  #undef GAPB
  #undef EX
  #undef VRD
  #undef KRD
  #undef STEP
  #undef ENDW
  {auto rr=__builtin_amdgcn_permlane32_swap(__float_as_uint(l_reg),__float_as_uint(l_reg),false,false);l_reg=__uint_as_float(rr[0])+__uint_as_float(rr[1]);}
  if(hi==0)wsf[32+r32]=l_reg;asm volatile("s_waitcnt lgkmcnt(0)":::"memory");
  float rli[16];
  #pragma unroll
  for(int r=0;r<16;++r)rli[r]=__builtin_amdgcn_rcpf(wsf[32+crow(r,hi)]);
  bf16*Ow=O+(rowbase+q0+wid*QBLK)*DM+h*D;
  { bf16*stg=(bf16*)(shm+LDS_OST)+wid*2048;
    #pragma unroll
    for(int r=0;r<16;++r){const int orow=crow(r,hi);
      #pragma unroll
      for(int d0=0;d0<2;++d0)stg[orow*64+d0*32+r32]=__float2bfloat16(o[d0][r]*rli[r]);}
    asm volatile("s_waitcnt lgkmcnt(0)":::"memory");
    #pragma unroll
    for(int i=0;i<4;++i){const int row=i*8+(lane>>3),ch=lane&7; const u32x4 v=*(const u32x4*)(stg+row*64+ch*8); ATTN_STORE16(Ow+(long)row*DM+ch*8,v);} }
  asm volatile("s_waitcnt lgkmcnt(0)\n\ts_barrier":::"memory");
  #undef DMA_K
  #undef DMA_V
  #undef CMASK
  #undef START
  #undef RESC
  #undef ROT
}
constexpr int ATTN_LDS_BYTES=LDS_BYTES;
constexpr int N_UNITS=8*8*NQB;
template<int THRL=8> __device__ __forceinline__ void attn_phase(char*lds,bf16*Z,int G,int vcu){
  for(int L=vcu;L<N_UNITS;L+=G){ const int pair=L>>7,rem=L&127,b=pair>>1,h=(pair&1)*4+(rem>>5),qb=rem&31;
    attn_unit<THRL>(b,h,qb,Z,Z+1024,Z+1152,Z,lds); }
}
#undef SBAR
#undef WAIT_BAR
}
constexpr int NWAVES = 8;
#ifndef MK_PER_PHASE
#define MK_PER_PHASE 0
#endif
constexpr int NPHASE = 16;

constexpr int NB = 8, SEQ = 8192, DMODEL = 1024, CTXL = 256, SROW = SEQ + CTXL  ;
constexpr int MC = NB * SROW  , ML = NB * SEQ  ;
constexpr int ZP = 2304;
constexpr int DFF = 2816, DFE = 1408, NEXP = 8, NMODV = 6 * DMODEL;
constexpr int MS_MAX = 2 * ML + NEXP * 256;
constexpr float EPS = 1e-6f;
constexpr float QSCALE = 0.125f * 1.4426950408889634f;

constexpr size_t MiB = 1u << 20;
constexpr size_t WS_CTL = 0, CTL_ZERO_BYTES = 1 * MiB;
constexpr size_t WS_MOD = 1 * MiB;
constexpr size_t WS_ROPE = WS_MOD + 512 * 1024;
constexpr size_t WS_HIST = WS_ROPE + 64 * 1024;
constexpr size_t WS_TOKE = 2 * MiB, WS_TOKR = WS_TOKE + 256 * 1024, WS_TOKP = WS_TOKR + 256 * 1024, WS_TOKS = WS_TOKP + 256 * 1024;
constexpr size_t WS_WIN = 8 * MiB, WS_WOUT = 13 * MiB, WS_WGU = 15 * MiB, WS_WD = 26 * MiB, WS_WP = 32 * MiB, WS_WEGU = 33 * MiB, WS_WED = 77 * MiB;
constexpr size_t WS_A = 104 * MiB;
constexpr size_t WS_R1 = 240 * MiB;
constexpr size_t WS_R2 = 600 * MiB;
constexpr size_t WS_END = 864 * MiB;
static_assert(WS_WED + (size_t)NEXP * 1024 * DFE * 2 <= WS_A && WS_A + (size_t)MC * 1024 * 2 <= WS_R1 && WS_R1 + (size_t)MS_MAX * DFE * 2 <= WS_R2 && WS_R1 + (size_t)ML * DFF * 2 <= WS_R2 && WS_R2 + (size_t)MS_MAX * 1024 * 2 <= WS_END, "d_ws map");
constexpr int CW_TMO = 0, CW_CODE = 1;
constexpr int CW_BAR = 4096;

constexpr int RING_OFF = 0, RING_BYTES = 131072;
constexpr int LDSCTL_OFF = RING_BYTES, MISC_OFF = LDSCTL_OFF + 320;
constexpr int LDS_BYTES = 147456;
static_assert(MISC_OFF + 128 <= LDS_BYTES, "LDS map");
#define GAS __attribute__((address_space(1)))
#define LAS __attribute__((address_space(3)))
typedef unsigned short bf16;
typedef unsigned v4u __attribute__((ext_vector_type(4)));
typedef float f32x4 __attribute__((ext_vector_type(4)));
typedef short bf16x8 __attribute__((ext_vector_type(8)));
typedef GAS unsigned gu32;
typedef GAS unsigned long long gu64;
#define RLX_AGENT __ATOMIC_RELAXED, __HIP_MEMORY_SCOPE_AGENT
#define LDS_WAIT() asm volatile("s_waitcnt lgkmcnt(0)" ::: "memory")
#define VM_WAIT() asm volatile("s_waitcnt vmcnt(0)" ::: "memory")
__device__ __forceinline__ unsigned long long rt() { return __builtin_amdgcn_s_memrealtime(); }
__device__ __forceinline__ unsigned f2bf(float f) { unsigned u = __builtin_bit_cast(unsigned, f); return (u + 0x7fffu + ((u >> 16) & 1u)) >> 16; }
__device__ __forceinline__ unsigned pk2(float lo, float hi) { return f2bf(lo) | (f2bf(hi) << 16); }

#define XB_TMO      128
#define XB_XCNT(j)  (256  + 64 * (j))
#define XB_XSUB(j)  (1280 + 64 * (j))
#define XB_XGEN(j)  (2304 + 64 * (j))
#define XB_TOP      3328
#define XB_TOPGEN   3392
#define XCD_BAR_WORDS 3456
#define XB_SPIN_CAP (1u << 18)

__device__ __forceinline__ unsigned xb_ld(unsigned* p)              { return __hip_atomic_load(p, __ATOMIC_RELAXED, __HIP_MEMORY_SCOPE_AGENT); }
__device__ __forceinline__ unsigned xb_add(unsigned* p, unsigned v) { return __hip_atomic_fetch_add(p, v, __ATOMIC_RELAXED, __HIP_MEMORY_SCOPE_AGENT); }
__device__ __forceinline__ unsigned xb_xcc_id() { return (unsigned)__builtin_amdgcn_s_getreg((3 << 11) | 20) & 0xFu; }
#define XB_SPIN(cond, bar) do { unsigned _sp = 0; while (cond) { __builtin_amdgcn_s_sleep(1); \
    if ((++_sp & 255u) == 0u) { if (xb_ld(&(bar)[XB_TMO])) break; if (_sp > XB_SPIN_CAP) { atomicAdd(&(bar)[XB_TMO], 1u); break; } } } } while (0)

struct XcdBarrier {
    unsigned* bar; unsigned x;
    volatile LAS unsigned* st;
};

__device__ __forceinline__ XcdBarrier xcd_barrier_post(unsigned* bar, volatile LAS unsigned* st) {
    XcdBarrier b; b.bar = bar; b.x = xb_xcc_id(); b.st = st;
    if (threadIdx.x == 0) (void)xb_add(&bar[XB_XCNT(b.x)], 1u);
    return b;
}
__device__ __forceinline__ void xcd_barrier_complete(unsigned* bar, unsigned x, unsigned& nloc, unsigned& nx) {
    const unsigned G = gridDim.x * gridDim.y * gridDim.z;
    unsigned sum, cnt, mine, sp = 0u;
    for (;;) {
        sum = 0u; cnt = 0u; mine = 0u;
#pragma unroll
        for (unsigned j = 0; j < 16; ++j) { const unsigned c = xb_ld(&bar[XB_XCNT(j)]); sum += c; cnt += (c > 0u) ? 1u : 0u; mine = (j == x) ? c : mine; }
        if (sum == G) break;
        __builtin_amdgcn_s_sleep(1);
        if ((++sp & 255u) == 0u) { if (xb_ld(&bar[XB_TMO])) break; if (sp > XB_SPIN_CAP) { atomicAdd(&bar[XB_TMO], 1u); break; } }
    }
    nloc = mine > 0u ? mine : 1u; nx = cnt > 0u ? cnt : 1u;
}

__device__ __forceinline__ void xcd_barrier(const XcdBarrier& b) {
    asm volatile("s_waitcnt vmcnt(0)" ::: "memory");
    __syncthreads();
    if (threadIdx.x == 0) {
        unsigned* bar = b.bar;
        __builtin_amdgcn_s_waitcnt(0);
        unsigned nloc = b.st[0], nx = b.st[1];
        if (nloc == 0u) { xcd_barrier_complete(bar, b.x, nloc, nx); b.st[0] = nloc; b.st[1] = nx; }
        const unsigned old = xb_add(&bar[XB_XSUB(b.x)], 1u);
        const unsigned gen = old / nloc;
        if (old + 1u == (gen + 1u) * nloc) {
            __builtin_amdgcn_fence(__ATOMIC_RELEASE, "agent");
            asm volatile("s_waitcnt vmcnt(0)" ::: "memory");
            const unsigned og = xb_add(&bar[XB_TOP], 1u);
            const unsigned tg = og / nx;
            if (og + 1u == (tg + 1u) * nx) xb_add(&bar[XB_TOPGEN], 1u);
            else XB_SPIN(xb_ld(&bar[XB_TOPGEN]) == tg, bar);
            __builtin_amdgcn_fence(__ATOMIC_ACQUIRE, "agent");
            xb_add(&bar[XB_XGEN(b.x)], 1u);
            asm volatile("s_waitcnt vmcnt(0)" ::: "memory");
        } else {
            XB_SPIN(xb_ld(&bar[XB_XGEN(b.x)]) == gen, bar);
            __builtin_amdgcn_fence(__ATOMIC_ACQUIRE, "agent");
            asm volatile("s_waitcnt vmcnt(0)" ::: "memory");
        }
    }
    __syncthreads();
}
struct Args { const float* in[23]; float* out; unsigned char* ws; int ph_lo, ph_hi; };
struct Frame {
    LAS unsigned char* lds;
    volatile LAS unsigned* MISC;
    gu32* ctl;
    unsigned char* ws;
    int tid, lane, wave;
    int vcu, G;
};
__device__ __forceinline__ float wave_sum(float v) {
#pragma unroll
    for (int o = 1; o < 64; o <<= 1) v += __shfl_xor(v, o);
    return v;
}
__device__ __forceinline__ float bf_lo(unsigned w) { return __uint_as_float(w << 16); }
__device__ __forceinline__ float bf_hi(unsigned w) { return __uint_as_float(w & 0xffff0000u); }
__device__ __forceinline__ unsigned pkbf(float lo, float hi) { return pg8::cvt_pk_bf16(lo, hi); }

struct GridOrder {
    int nM, nN, G, c; bool mapA;
    __device__ __forceinline__ bool next(int i, pg8::Unit& u) const {
        const long L = (long)i * G + c; if (L >= (long)nM * nN) return false;
        int pm, pn; pg8::tile_map((int)L, nM, nN, pm, pn); u.om = pm; u.pm = mapA ? pm + (pm >> 5) + 1 : pm; u.pn = pn; u.e = 0; return true; }
    __device__ __forceinline__ void a_ready(const pg8::Unit&) const {}
    __device__ __forceinline__ void done(const pg8::Unit&) const {}
};
struct InProjOrder {
    int G, c;
    __device__ __forceinline__ bool next(int i, pg8::Unit& u) const {
        const long L = (long)i * G + c; if (L >= 2304 + NB) return false;
        if (L < 2304) { int pm, pn; pg8::tile_map((int)L, 256, 9, pm, pn); u.pm = pm + (pm >> 5) + 1; u.pn = pn; }
        else { u.pm = ((int)L - 2304) * 33; u.pn = 4; }
        u.om = u.pm; u.e = 0; return true; }
    __device__ __forceinline__ void a_ready(const pg8::Unit&) const {}
    __device__ __forceinline__ void done(const pg8::Unit&) const {}
};
struct MoeOrder {
    int nM, nN, G, c; int ts1, ts2, ts3, ts4, ts5, ts6, ts7;
    __device__ __forceinline__ bool next(int i, pg8::Unit& u) const {
        const long L = (long)i * G + c; if (L >= (long)nM * nN) return false;
        int pm, pn; pg8::tile_map((int)L, nM, nN, pm, pn); u.pm = pm; u.om = pm; u.pn = pn;
        u.e = (pm >= ts1) + (pm >= ts2) + (pm >= ts3) + (pm >= ts4) + (pm >= ts5) + (pm >= ts6) + (pm >= ts7); return true; }
    __device__ __forceinline__ void a_ready(const pg8::Unit&) const {}
    __device__ __forceinline__ void done(const pg8::Unit&) const {}
};

__device__ __forceinline__ void p0_transpose_item(const float* W, int N, bf16* WT, int Kd, int k0, int n0, int drow0, LAS float* scr, int lane) {
#pragma unroll 8
    for (int i = 0; i < 32; ++i) { const int kk = 2 * i + (lane >> 5); scr[kk * 33 + (lane & 31)] = W[(size_t)(k0 + kk) * N + n0 + (lane & 31)]; }
    LDS_WAIT(); asm volatile("" ::: "memory");
    const int c = lane & 7;
#pragma unroll
    for (int j = 0; j < 4; ++j) { const int n = (lane >> 3) + 8 * j; const LAS float* s = scr + (8 * c) * 33 + n;
        v4u o; o.x = pkbf(s[0 * 33], s[1 * 33]); o.y = pkbf(s[2 * 33], s[3 * 33]); o.z = pkbf(s[4 * 33], s[5 * 33]); o.w = pkbf(s[6 * 33], s[7 * 33]);
        *(GAS v4u*)(WT + (size_t)(drow0 + n) * Kd + k0 + 8 * c) = o; }
    LDS_WAIT(); asm volatile("" ::: "memory");
}
__device__ __forceinline__ bool p0_mats(int& it, const float* W, int K, int N, bf16* WT, int maptype, int half, int nmat, int dstN, LAS float* scr, int lane) {
    const int nblk = N / 32, per = (K / 64) * nblk, nitems = per * nmat;
    if (it >= nitems) { it -= nitems; return false; }
    const int e = it / per, r = it - e * per, kb = r / nblk, nb = r - kb * nblk, k0 = 64 * kb, n0 = 32 * nb;
    int d;
    if (maptype == 0) d = n0;
    else if (maptype == 1) d = n0 < 512 ? n0 : n0 < 768 ? n0 + 512 : n0 < 1280 ? n0 - 256 : n0;
    else d = (n0 >> 7) * 256 + (n0 & 127) + half * 128;
    p0_transpose_item(W + (size_t)e * K * N, N, WT + (size_t)e * dstN * K, K, k0, n0, d, scr, lane);
    return true;
}
__device__ __forceinline__ void p0_prologue(const Args& a, const Frame& F) {
    float* mod = (float*)(F.ws + WS_MOD);
    { LAS float* sl = (LAS float*)(F.lds + RING_OFF); LAS float* red = sl + 9 * 1024;
      for (int idx = F.tid; idx < 9 * 1024; idx += NWAVES * 64) { const int r = idx >> 10, k = idx & 1023; const float v = r < 8 ? a.in[1][r * 1024 + k] : a.in[3][k]; sl[idx] = v / (1.0f + __expf(-v)); }
      __syncthreads();
      for (int task = blockIdx.x; task < 192; task += F.G) { const int i = task / 96, n0 = (task % 96) * 64;
          float acc[9];
#pragma unroll
          for (int r = 0; r < 9; ++r) acc[r] = 0.f;
          const float* wp = a.in[4] + ((size_t)i * 1024 + F.wave * 128) * NMODV + n0 + F.lane;
#pragma unroll 4
          for (int k = 0; k < 128; ++k) { const float wv = wp[(size_t)k * NMODV];
#pragma unroll
              for (int r = 0; r < 9; ++r) acc[r] += sl[r * 1024 + F.wave * 128 + k] * wv; }
#pragma unroll
          for (int r = 0; r < 9; ++r) red[(F.wave * 9 + r) * 64 + F.lane] = acc[r];
          __syncthreads();
          for (int idx = F.tid; idx < 9 * 64; idx += NWAVES * 64) { const int r = idx >> 6, l = idx & 63; float s = 0.f;
#pragma unroll
              for (int w = 0; w < 8; ++w) s += red[(w * 9 + r) * 64 + l];
              mod[(size_t)(i * 9 + r) * NMODV + n0 + l] = s + a.in[5][i * NMODV + n0 + l]; }
          __syncthreads(); }
    }
    { float* rt_ = (float*)(F.ws + WS_ROPE); const int gt = blockIdx.x * (NWAVES * 64) + F.tid;
      if (gt < 192 * 16) { const int p = gt >> 4, i = gt & 15; const float pos = (float)(p < 128 ? p : p - 128); const float freq = exp2f(-(float)i * (13.287712379549449f / 16.0f)); const float ang = pos * freq;
          rt_[gt * 2] = cosf(ang); rt_[gt * 2 + 1] = sinf(ang); } }
    __syncthreads();
    LAS float* scr = (LAS float*)(F.lds + RING_OFF + F.wave * 16384);
    const int gw = F.vcu * NWAVES + F.wave, NGW = F.G * NWAVES;
    constexpr int NITEMS = 1152 + 512 + 3 * 1408 + 128 + 3 * 5632;
    for (int it0 = gw; it0 < NITEMS; it0 += NGW) { int it = it0;
        if (p0_mats(it, a.in[8], 1024, 2304, (bf16*)(F.ws + WS_WIN), 1, 0, 1, 2304, scr, F.lane)) continue;
        if (p0_mats(it, a.in[12], 1024, 1024, (bf16*)(F.ws + WS_WOUT), 0, 0, 1, 1024, scr, F.lane)) continue;
        if (p0_mats(it, a.in[13], 1024, DFF, (bf16*)(F.ws + WS_WGU), 2, 0, 1, 2 * DFF, scr, F.lane)) continue;
        if (p0_mats(it, a.in[14], 1024, DFF, (bf16*)(F.ws + WS_WGU), 2, 1, 1, 2 * DFF, scr, F.lane)) continue;
        if (p0_mats(it, a.in[15], DFF, 1024, (bf16*)(F.ws + WS_WD), 0, 0, 1, 1024, scr, F.lane)) continue;
        if (p0_mats(it, a.in[16], 256, 256, (bf16*)(F.ws + WS_WP), 0, 0, 4, 256, scr, F.lane)) continue;
        if (p0_mats(it, a.in[20], 1024, DFE, (bf16*)(F.ws + WS_WEGU), 2, 0, NEXP, 2 * DFE, scr, F.lane)) continue;
        if (p0_mats(it, a.in[21], 1024, DFE, (bf16*)(F.ws + WS_WEGU), 2, 1, NEXP, 2 * DFE, scr, F.lane)) continue;
        p0_mats(it, a.in[22], DFE, 1024, (bf16*)(F.ws + WS_WED), 0, 0, NEXP, 1024, scr, F.lane);
    }
}

template <int MODE> __device__ __forceinline__ void norm_mod_phase(const Args& a, const Frame& F) {
    const int gw = F.vcu * NWAVES + F.wave, NGW = F.G * NWAVES;
    constexpr int nrows = MODE == 0 ? MC : ML; const int rpw = (nrows + NGW - 1) / NGW;
    const float* mod = (const float*)(F.ws + WS_MOD); const float* ng = a.in[6] + (MODE == 0 ? 0 : 1024);
    constexpr int SH = MODE == 0 ? 0 : 3, SC = SH + 1;
    bf16* A = (bf16*)(F.ws + WS_A);
    int cur_r = -1; f32x4 gm[4], sh[4];
    int R1 = (gw + 1) * rpw; if (R1 > nrows) R1 = nrows;
    for (int R = gw * rpw; R < R1; ++R) {
        const float* src; int r;
        if (MODE == 0) { const int b = R / SROW, s = R - b * SROW; if (s < CTXL) { src = a.in[2] + ((size_t)b * CTXL + s) * 1024; r = 8; } else { src = a.in[0] + ((size_t)b * SEQ + (s - CTXL)) * 1024; r = b; } }
        else { src = a.out + (size_t)R * 1024; r = R / SEQ; }
        if (r != cur_r) { cur_r = r;
#pragma unroll
            for (int j = 0; j < 4; ++j) { const int col = 4 * F.lane + 256 * j; const f32x4 g = *(const f32x4*)(ng + col), sc = *(const f32x4*)(mod + (size_t)r * NMODV + SC * 1024 + col);
                gm[j] = g * (sc + 1.0f); sh[j] = *(const f32x4*)(mod + (size_t)r * NMODV + SH * 1024 + col); } }
        f32x4 v[4]; float ss = 0.f;
#pragma unroll
        for (int j = 0; j < 4; ++j) { v[j] = *(const GAS f32x4*)(src + 4 * F.lane + 256 * j); ss += (v[j].x * v[j].x + v[j].y * v[j].y) + (v[j].z * v[j].z + v[j].w * v[j].w); }
        const float rstd = rsqrtf(wave_sum(ss) * (1.0f / 1024.0f) + EPS);
#pragma unroll
        for (int j = 0; j < 4; ++j) { const f32x4 o = v[j] * rstd * gm[j] + sh[j];
            *(GAS unsigned long long*)(A + (size_t)R * 1024 + 4 * F.lane + 256 * j) = (unsigned long long)pkbf(o.x, o.y) | ((unsigned long long)pkbf(o.z, o.w) << 32); }
    }
}

__device__ __forceinline__ void unpack8(const v4u w, float (&v)[8]) { v[0] = bf_lo(w.x); v[1] = bf_hi(w.x); v[2] = bf_lo(w.y); v[3] = bf_hi(w.y); v[4] = bf_lo(w.z); v[5] = bf_hi(w.z); v[6] = bf_lo(w.w); v[7] = bf_hi(w.w); }
__device__ __forceinline__ v4u pack8(const float (&v)[8]) { v4u w; w.x = pkbf(v[0], v[1]); w.y = pkbf(v[2], v[3]); w.z = pkbf(v[4], v[5]); w.w = pkbf(v[6], v[7]); return w; }
__device__ __forceinline__ v4u qk_head(const v4u w, const float* g8, const float* ropeT, bool do_rope, int prow, int pcol, float scale, int lane) {
    float v[8]; unpack8(w, v); float ss = 0.f;
#pragma unroll
    for (int e = 0; e < 8; ++e) ss += v[e] * v[e];
    ss += __shfl_xor(ss, 1); ss += __shfl_xor(ss, 2); ss += __shfl_xor(ss, 4);
    const float rstd = rsqrtf(ss * (1.0f / 64.0f) + EPS);
    const f32x4 g0 = *(const f32x4*)g8, g1 = *(const f32x4*)(g8 + 4);
    v[0] *= rstd * g0.x; v[1] *= rstd * g0.y; v[2] *= rstd * g0.z; v[3] *= rstd * g0.w; v[4] *= rstd * g1.x; v[5] *= rstd * g1.y; v[6] *= rstd * g1.z; v[7] *= rstd * g1.w;
    if (do_rope) {
        const int axis = (lane >> 2) & 1, pos = axis ? 128 + pcol : prow; const float* tp = ropeT + ((size_t)pos * 16 + (lane & 1) * 8) * 2; const bool second = (lane & 2) != 0;
#pragma unroll
        for (int e = 0; e < 8; ++e) { const float other = __shfl_xor(v[e], 2); const float c = tp[2 * e], s = tp[2 * e + 1];
            v[e] = second ? (other * s + v[e] * c) : (v[e] * c - other * s); }
    }
#pragma unroll
    for (int e = 0; e < 8; ++e) v[e] *= scale;
    return pack8(v);
}
__device__ __forceinline__ void gcu_prod(const bf16* zr, int lane, float (&o)[8]) {
    const v4u gc = *(const GAS v4u*)(zr + 1280 + lane * 8), uu = *(const GAS v4u*)(zr + 1792 + lane * 8); float x[8], y[8]; unpack8(gc, x); unpack8(uu, y);
#pragma unroll
    for (int e = 0; e < 8; ++e) o[e] = x[e] * y[e];
}
__device__ __forceinline__ void p3_postproc(const Args& a, const Frame& F) {
    const int gw = F.vcu * NWAVES + F.wave, NGW = F.G * NWAVES, lane = F.lane;
    bf16* Z = (bf16*)(F.ws + WS_R1); const float* ropeT = (const float*)(F.ws + WS_ROPE);
    const float* qg = a.in[9] + (lane & 7) * 8; const float* kg = a.in[10] + (lane & 7) * 8;
    for (int i = gw; i < NB * CTXL; i += NGW) { const int b = i / CTXL, s = i - b * CTXL; bf16* zr = Z + (size_t)(b * SROW + s) * ZP;
        if (lane < 16) { const v4u w = *(const GAS v4u*)(zr + 1024 + lane * 8); *(GAS v4u*)(zr + 1024 + lane * 8) = qk_head(w, kg, ropeT, false, 0, 0, 1.0f, lane); } }
    f32x4 cw[3][2];
#pragma unroll
    for (int t = 0; t < 3; ++t) { cw[t][0] = *(const f32x4*)(a.in[11] + t * 512 + lane * 8); cw[t][1] = *(const f32x4*)(a.in[11] + t * 512 + lane * 8 + 4); }
    for (int ch = gw; ch < ML / 32; ch += NGW) {
        const int n0 = ch * 32, b = n0 / SEQ, t0 = n0 - b * SEQ; bf16* z0 = Z + (size_t)(b * SROW + CTXL + t0) * ZP;
        float prev[8], cur[8], nxt[8];
        if (t0 > 0) gcu_prod(z0 - ZP, lane, prev); else {
#pragma unroll
            for (int e = 0; e < 8; ++e) prev[e] = 0.f; }
        gcu_prod(z0, lane, cur);
        for (int i = 0; i < 32; ++i) { const int t = t0 + i; bf16* zr = z0 + (size_t)i * ZP;
            if (t + 1 < SEQ) gcu_prod(zr + ZP, lane, nxt); else {
#pragma unroll
                for (int e = 0; e < 8; ++e) nxt[e] = 0.f; }
            { const v4u gbw = *(const GAS v4u*)(zr + 512 + lane * 8); float gb[8], o[8]; unpack8(gbw, gb);
              const float w0[8] = {cw[0][0].x, cw[0][0].y, cw[0][0].z, cw[0][0].w, cw[0][1].x, cw[0][1].y, cw[0][1].z, cw[0][1].w};
              const float w1[8] = {cw[1][0].x, cw[1][0].y, cw[1][0].z, cw[1][0].w, cw[1][1].x, cw[1][1].y, cw[1][1].z, cw[1][1].w};
              const float w2[8] = {cw[2][0].x, cw[2][0].y, cw[2][0].z, cw[2][0].w, cw[2][1].x, cw[2][1].y, cw[2][1].z, cw[2][1].w};
#pragma unroll
              for (int e = 0; e < 8; ++e) { o[e] = gb[e] * (w0[e] * prev[e] + w1[e] * cur[e] + w2[e] * nxt[e]); prev[e] = cur[e]; cur[e] = nxt[e]; }
              *(GAS v4u*)(zr + 512 + lane * 8) = pack8(o); }
            const int prow = t >> 6, pcol = t & 63;
            { const v4u w = *(const GAS v4u*)(zr + lane * 8); *(GAS v4u*)(zr + lane * 8) = qk_head(w, qg, ropeT, true, prow, pcol, QSCALE, lane); }
            if (lane < 16) { const v4u w = *(const GAS v4u*)(zr + 1024 + lane * 8); *(GAS v4u*)(zr + 1024 + lane * 8) = qk_head(w, kg, ropeT, true, prow, pcol, 1.0f, lane); }
        }
    }
}
__device__ __forceinline__ void p9_pool(const Args& a, const Frame& F) {
    LAS float* rs = (LAS float*)(F.lds + RING_OFF);
    LAS float* tile = (LAS float*)(F.lds + RING_OFF + 1024);
    const float* mod = (const float*)(F.ws + WS_MOD) + (size_t)9 * NMODV; const float* ng = a.in[6] + 2 * 1024;
    bf16* P = (bf16*)(F.ws + WS_A); const float* X = a.out;
    for (int u = F.vcu; u < ML / 64; u += F.G) {
        const int n0 = u * 64, b = n0 / SEQ, t0 = n0 - b * SEQ; const float* xb = X + (size_t)b * SEQ * 1024;
        for (int j = F.wave * 10; j < F.wave * 10 + 10; ++j) { const int tt = t0 - 8 + j; float r = 0.f;
            if (tt >= 0 && tt < SEQ) { float ss = 0.f;
#pragma unroll
                for (int q = 0; q < 4; ++q) { const f32x4 v = *(const GAS f32x4*)(xb + (size_t)tt * 1024 + 4 * F.lane + 256 * q); ss += (v.x * v.x + v.y * v.y) + (v.z * v.z + v.w * v.w); }
                r = rsqrtf(wave_sum(ss) * (1.0f / 1024.0f) + EPS); }
            if (F.lane == 0) rs[j] = r; }
        __syncthreads();
#pragma unroll 1
        for (int g = 0; g < 4; ++g) {
            { const int col = g * 256 + 4 * F.lane; const f32x4 gg = *(const f32x4*)(ng + col), sc = *(const f32x4*)(mod + (size_t)b * NMODV + 1024 + col), sh = *(const f32x4*)(mod + (size_t)b * NMODV + col);
              const f32x4 gm = gg * (sc + 1.0f);
              for (int j = F.wave; j < 80; j += NWAVES) { const int tt = t0 - 8 + j; f32x4 o = (f32x4){0.f, 0.f, 0.f, 0.f};
                  if (tt >= 0 && tt < SEQ) { const f32x4 v = *(const GAS f32x4*)(xb + (size_t)tt * 1024 + col); o = v * rs[j] * gm + sh; }
                  *(LAS f32x4*)(tile + j * 256 + 4 * F.lane) = o; } }
            __syncthreads();
            { const int c2 = (F.tid & 127) * 2, i0 = (F.tid >> 7) * 16, hw = 1 << g;
              typedef float f32x2 __attribute__((ext_vector_type(2)));
              f32x2 sum = (f32x2){0.f, 0.f};
              for (int jj = i0 + 8 - hw; jj < i0 + 8 + hw; ++jj) sum += *(const LAS f32x2*)(tile + jj * 256 + c2);
              for (int i = i0; i < i0 + 16; ++i) { const int j = i + 8, t = t0 + i; const int lo = t - hw < 0 ? 0 : t - hw, hi = t + hw > SEQ ? SEQ : t + hw;
                  const float inv = 1.0f / (float)(hi - lo); const f32x2 at = *(const LAS f32x2*)(tile + j * 256 + c2); const f32x2 p = sum * inv - at;
                  *(GAS unsigned*)(P + (size_t)(n0 + i) * 1024 + g * 256 + c2) = pkbf(p.x, p.y);
                  if (i + 1 < i0 + 16) sum += *(const LAS f32x2*)(tile + (j + hw) * 256 + c2) - *(const LAS f32x2*)(tile + (j - hw) * 256 + c2); } }
            __syncthreads();
        }
    }
}

__device__ __forceinline__ void p11a_router(const Args& a, const Frame& F) {
    LAS float* rw = (LAS float*)(F.lds + RING_OFF);
    LAS int* e1s = (LAS int*)(F.lds + RING_OFF + 32768); LAS int* e2s = e1s + 256; LAS int* r1s = e2s + 256; LAS int* r2s = r1s + 256;
    const float* mod = (const float*)(F.ws + WS_MOD) + (size_t)9 * NMODV; const float* ng = a.in[6] + 3 * 1024;
    bf16* A = (bf16*)(F.ws + WS_A); const float* X = a.out;
    unsigned* hist = (unsigned*)(F.ws + WS_HIST); unsigned* toke = (unsigned*)(F.ws + WS_TOKE); unsigned* tokr = (unsigned*)(F.ws + WS_TOKR); float* tokp = (float*)(F.ws + WS_TOKP);
    for (int idx = F.tid; idx < 1024 * 8 / 4; idx += NWAVES * 64) *(LAS f32x4*)(rw + 4 * idx) = *(const f32x4*)(a.in[18] + 4 * idx);
    __syncthreads();
    float rb[8];
#pragma unroll
    for (int e = 0; e < 8; ++e) rb[e] = a.in[19][e];
    for (int ch = F.vcu; ch < ML / 256; ch += F.G) {
        const int b = (ch * 256) / SEQ;
        f32x4 gm[4], sh[4];
#pragma unroll
        for (int j = 0; j < 4; ++j) { const int col = 4 * F.lane + 256 * j; const f32x4 g = *(const f32x4*)(ng + col), sc = *(const f32x4*)(mod + (size_t)b * NMODV + 4 * 1024 + col);
            gm[j] = g * (sc + 1.0f); sh[j] = *(const f32x4*)(mod + (size_t)b * NMODV + 3 * 1024 + col); }
        for (int i = 0; i < 32; ++i) { const int tl = F.wave * 32 + i, n = ch * 256 + tl;
            f32x4 v[4]; float ss = 0.f;
#pragma unroll
            for (int j = 0; j < 4; ++j) { v[j] = *(const GAS f32x4*)(X + (size_t)n * 1024 + 4 * F.lane + 256 * j); ss += (v[j].x * v[j].x + v[j].y * v[j].y) + (v[j].z * v[j].z + v[j].w * v[j].w); }
            const float rstd = rsqrtf(wave_sum(ss) * (1.0f / 1024.0f) + EPS);
            float lg[8];
#pragma unroll
            for (int e = 0; e < 8; ++e) lg[e] = 0.f;
#pragma unroll
            for (int j = 0; j < 4; ++j) { const f32x4 o = v[j] * rstd * gm[j] + sh[j];
                *(GAS unsigned long long*)(A + (size_t)n * 1024 + 4 * F.lane + 256 * j) = (unsigned long long)pkbf(o.x, o.y) | ((unsigned long long)pkbf(o.z, o.w) << 32);
                const float of[4] = {o.x, o.y, o.z, o.w};
#pragma unroll
                for (int q = 0; q < 4; ++q) { const LAS float* wr_ = rw + (size_t)(4 * F.lane + 256 * j + q) * 8; const f32x4 w0 = *(const LAS f32x4*)wr_, w1 = *(const LAS f32x4*)(wr_ + 4);
                    lg[0] += of[q] * w0.x; lg[1] += of[q] * w0.y; lg[2] += of[q] * w0.z; lg[3] += of[q] * w0.w; lg[4] += of[q] * w1.x; lg[5] += of[q] * w1.y; lg[6] += of[q] * w1.z; lg[7] += of[q] * w1.w; } }
#pragma unroll
            for (int e = 0; e < 8; ++e) lg[e] = wave_sum(lg[e]) + rb[e];
            int i1 = 0; float v1 = lg[0];
#pragma unroll
            for (int e = 1; e < 8; ++e) if (lg[e] > v1) { v1 = lg[e]; i1 = e; }
            int i2 = -1; float v2 = -INFINITY;
#pragma unroll
            for (int e = 0; e < 8; ++e) if (e != i1 && lg[e] > v2) { v2 = lg[e]; i2 = e; }
            if (i2 < 0) i2 = (i1 + 1) & 7;
            const float p1 = 1.0f / (1.0f + __expf(v2 - v1));
            if (F.lane == 0) { e1s[tl] = i1; e2s[tl] = i2; tokp[n] = p1; }
        }
        __syncthreads();
        if (F.tid < 8) { const int e = F.tid; int cnt = 0;
            for (int j = 0; j < 256; ++j) { if (e1s[j] == e) r1s[j] = cnt++; if (e2s[j] == e) r2s[j] = cnt++; }
            hist[ch * 8 + e] = (unsigned)cnt; }
        __syncthreads();
        if (F.tid < 256) { const int n = ch * 256 + F.tid; toke[n] = (unsigned)e1s[F.tid] | ((unsigned)e2s[F.tid] << 8); tokr[n] = (unsigned)r1s[F.tid] | ((unsigned)r2s[F.tid] << 16); }
        __syncthreads();
    }
}
__device__ __forceinline__ void moe_offsets(const Frame& F) {
    LAS unsigned* pre = (LAS unsigned*)(F.lds + RING_OFF); LAS unsigned* offs = (LAS unsigned*)(F.lds + LDSCTL_OFF); LAS unsigned* tot = offs + 16;
    const unsigned* hist = (const unsigned*)(F.ws + WS_HIST);
    for (int idx = F.tid; idx < 2048; idx += NWAVES * 64) pre[idx] = hist[idx];
    __syncthreads();
    if (F.tid < 8) { unsigned run = 0; for (int ch = 0; ch < 256; ++ch) { const unsigned h = pre[ch * 8 + F.tid]; pre[ch * 8 + F.tid] = run; run += h; } tot[F.tid] = run; }
    __syncthreads();
    if (F.tid == 0) { unsigned o = 0; for (int e = 0; e < 8; ++e) { offs[e] = o; o += (tot[e] + 255u) & ~255u; } offs[8] = o; }
    __syncthreads();
}
__device__ __forceinline__ void p11b_sort(const Args& a, const Frame& F) {
    moe_offsets(F);
    LAS unsigned* pre = (LAS unsigned*)(F.lds + RING_OFF); LAS unsigned* offs = (LAS unsigned*)(F.lds + LDSCTL_OFF);
    const bf16* A = (const bf16*)(F.ws + WS_A); bf16* As = (bf16*)(F.ws + WS_R2);
    const unsigned* toke = (const unsigned*)(F.ws + WS_TOKE); const unsigned* tokr = (const unsigned*)(F.ws + WS_TOKR); unsigned* toks = (unsigned*)(F.ws + WS_TOKS);
    const int gw = F.vcu * NWAVES + F.wave, NGW = F.G * NWAVES; const int rpw = (ML + NGW - 1) / NGW;
    int n1 = (gw + 1) * rpw; if (n1 > ML) n1 = ML;
    for (int n = gw * rpw; n < n1; ++n) { const unsigned ee = toke[n], rr = tokr[n]; const int ch = n >> 8; const unsigned e1 = ee & 255u, e2 = ee >> 8;
        const unsigned s1 = offs[e1] + pre[ch * 8 + e1] + (rr & 0xffffu), s2 = offs[e2] + pre[ch * 8 + e2] + (rr >> 16);
        const v4u x0 = *(const GAS v4u*)(A + (size_t)n * 1024 + F.lane * 8), x1 = *(const GAS v4u*)(A + (size_t)n * 1024 + 512 + F.lane * 8);
        *(GAS v4u*)(As + (size_t)s1 * 1024 + F.lane * 8) = x0; *(GAS v4u*)(As + (size_t)s1 * 1024 + 512 + F.lane * 8) = x1;
        *(GAS v4u*)(As + (size_t)s2 * 1024 + F.lane * 8) = x0; *(GAS v4u*)(As + (size_t)s2 * 1024 + 512 + F.lane * 8) = x1;
        if (F.lane == 0) { toks[2 * n] = s1; toks[2 * n + 1] = s2; } }
}
__device__ __forceinline__ void p14_final(const Args& a, const Frame& F) {
    const int gw = F.vcu * NWAVES + F.wave, NGW = F.G * NWAVES; const int rpw = (ML + NGW - 1) / NGW;
    const float* mod = (const float*)(F.ws + WS_MOD) + (size_t)9 * NMODV; const bf16* Y = (const bf16*)(F.ws + WS_R2);
    const unsigned* toks = (const unsigned*)(F.ws + WS_TOKS); const float* tokp = (const float*)(F.ws + WS_TOKP);
    f32x4 fg[4];
#pragma unroll
    for (int j = 0; j < 4; ++j) fg[j] = *(const f32x4*)(a.in[7] + 4 * F.lane + 256 * j);
    int cur_b = -1; f32x4 g2[4];
    int n1 = (gw + 1) * rpw; if (n1 > ML) n1 = ML;
    for (int n = gw * rpw; n < n1; ++n) { const int b = n / SEQ;
        if (b != cur_b) { cur_b = b;
#pragma unroll
            for (int j = 0; j < 4; ++j) g2[j] = *(const f32x4*)(mod + (size_t)b * NMODV + 5 * 1024 + 4 * F.lane + 256 * j); }
        const unsigned s1 = toks[2 * n], s2 = toks[2 * n + 1]; const float p1 = tokp[n], p2 = 1.0f - p1;
        f32x4 v[4]; float ss = 0.f;
#pragma unroll
        for (int j = 0; j < 4; ++j) { const int col = 4 * F.lane + 256 * j; const f32x4 x = *(const GAS f32x4*)(a.out + (size_t)n * 1024 + col);
            const unsigned long long y1 = *(const GAS unsigned long long*)(Y + (size_t)s1 * 1024 + col), y2 = *(const GAS unsigned long long*)(Y + (size_t)s2 * 1024 + col);
            const unsigned a0 = (unsigned)y1, a1 = (unsigned)(y1 >> 32), b0 = (unsigned)y2, b1 = (unsigned)(y2 >> 32);
            f32x4 m; m.x = p1 * bf_lo(a0) + p2 * bf_lo(b0); m.y = p1 * bf_hi(a0) + p2 * bf_hi(b0); m.z = p1 * bf_lo(a1) + p2 * bf_lo(b1); m.w = p1 * bf_hi(a1) + p2 * bf_hi(b1);
            v[j] = x + g2[j] * m; ss += (v[j].x * v[j].x + v[j].y * v[j].y) + (v[j].z * v[j].z + v[j].w * v[j].w); }
        const float rstd = rsqrtf(wave_sum(ss) * (1.0f / 1024.0f) + EPS);
#pragma unroll
        for (int j = 0; j < 4; ++j) *(GAS f32x4*)(a.out + (size_t)n * 1024 + 4 * F.lane + 256 * j) = v[j] * rstd * fg[j];
    }
}
__global__ void __launch_bounds__(NWAVES * 64, 2) fwd_kernel(Args args) {
    extern __shared__ __attribute__((aligned(16))) unsigned char lds[];
    Frame F;
    F.lds = (LAS unsigned char*)lds;
    F.MISC = (volatile LAS unsigned*)(F.lds + MISC_OFF);
    F.tid = threadIdx.x; F.lane = F.tid & 63; F.wave = __builtin_amdgcn_readfirstlane(F.tid >> 6);
    F.G = gridDim.x; { const int bx = blockIdx.x; F.vcu = (F.G % 8 == 0) ? (bx % 8) * (F.G / 8) + bx / 8 : bx; }
    F.ws = args.ws; F.ctl = (gu32*)(args.ws + WS_CTL);
    for (int u = F.tid; u < (LDS_BYTES - LDSCTL_OFF) / 4; u += NWAVES * 64) ((LAS unsigned*)(F.lds + LDSCTL_OFF))[u] = 0u;
    __syncthreads();
    XcdBarrier bar; bar.bar = (unsigned*)(F.ctl + CW_BAR); bar.x = 0; bar.st = nullptr;
    if (!MK_PER_PHASE) bar = xcd_barrier_post((unsigned*)(F.ctl + CW_BAR), F.MISC + 8);
    const int lo = args.ph_lo, hi = args.ph_hi;
#define IN(k) (lo <= (k) && (k) < hi)
#define SEAM(k) do { if (IN(k) && IN((k) + 1)) xcd_barrier(bar); } while (0)
    bf16* const WA = (bf16*)(F.ws + WS_A); bf16* const R1 = (bf16*)(F.ws + WS_R1); bf16* const R2 = (bf16*)(F.ws + WS_R2);
    const float* const mod0 = (const float*)(F.ws + WS_MOD); const float* const mod1 = mod0 + (size_t)9 * NMODV;

    if (IN(0)) { p0_prologue(args, F); } SEAM(0);
    if (IN(1)) { norm_mod_phase<0>(args, F); } SEAM(1);
    if (IN(2)) { pg8::Gemm g{WA, (const bf16*)(F.ws + WS_WIN), 1024, 1024, 1024, 0, 0}; InProjOrder S{F.G, (int)blockIdx.x}; pg8::EpiBf16 E{R1, ZP};
        pg8::gemm_phase<pg8::EpiBf16, InProjOrder, true, true>(F.lds + RING_OFF, g, S, E); } SEAM(2);
    if (IN(3)) { p3_postproc(args, F); } SEAM(3);
    if (IN(4)) { attn_body::attn_phase<8>((char*)lds + RING_OFF, (attn_body::bf16*)R1, F.G, F.vcu); } SEAM(4);
    if (IN(5)) { pg8::Gemm g{R1, (const bf16*)(F.ws + WS_WOUT), 1024, ZP, 1024, 0, 0}; GridOrder S{256, 4, F.G, (int)blockIdx.x, true}; pg8::EpiRes E{args.in[0], args.out, mod0 + 2 * 1024, NMODV, nullptr};
        pg8::gemm_phase<pg8::EpiRes, GridOrder, true, true>(F.lds + RING_OFF, g, S, E); } SEAM(5);
    if (IN(6)) { norm_mod_phase<1>(args, F); } SEAM(6);
    if (IN(7)) { pg8::Gemm g{WA, (const bf16*)(F.ws + WS_WGU), 1024, 1024, 1024, 0, 0}; GridOrder S{256, 22, F.G, (int)blockIdx.x, false}; pg8::EpiSwiGLU E{R1, DFF};
        pg8::gemm_phase<pg8::EpiSwiGLU, GridOrder, true, true>(F.lds + RING_OFF, g, S, E); } SEAM(7);
    if (IN(8)) { pg8::Gemm g{R1, (const bf16*)(F.ws + WS_WD), DFF, DFF, DFF, 0, 0}; GridOrder S{256, 4, F.G, (int)blockIdx.x, false}; pg8::EpiRes E{args.out, args.out, mod0 + 5 * 1024, NMODV, nullptr};
        pg8::gemm_phase<pg8::EpiRes, GridOrder, true, true>(F.lds + RING_OFF, g, S, E); } SEAM(8);
    if (IN(9)) { p9_pool(args, F); } SEAM(9);
    if (IN(10)) { pg8::Gemm g{WA, (const bf16*)(F.ws + WS_WP), 256, 1024, 256, 512, 0}; GridOrder S{256, 4, F.G, (int)blockIdx.x, false}; pg8::EpiRes E{args.out, args.out, mod1 + 2 * 1024, NMODV, args.in[17]};
        pg8::gemm_phase<pg8::EpiRes, GridOrder, true, true>(F.lds + RING_OFF, g, S, E); } SEAM(10);
    if (IN(11)) { p11a_router(args, F); } SEAM(11);
    if (IN(12)) { p11b_sort(args, F); } SEAM(12);
    if (IN(13)) { moe_offsets(F); const LAS unsigned* offs = (const LAS unsigned*)(F.lds + LDSCTL_OFF);
        int ts[9];
#pragma unroll
        for (int e = 0; e < 9; ++e) ts[e] = __builtin_amdgcn_readfirstlane((int)(offs[e] >> 8));
        pg8::Gemm g{R2, (const bf16*)(F.ws + WS_WEGU), 1024, 1024, 1024, 0, (size_t)2 * DFE * 1024 * 2}; MoeOrder S{ts[8], 11, F.G, (int)blockIdx.x, ts[1], ts[2], ts[3], ts[4], ts[5], ts[6], ts[7]}; pg8::EpiSwiGLU E{R1, DFE};
        pg8::gemm_phase<pg8::EpiSwiGLU, MoeOrder, true, true>(F.lds + RING_OFF, g, S, E); } SEAM(13);
    if (IN(14)) { moe_offsets(F); const LAS unsigned* offs = (const LAS unsigned*)(F.lds + LDSCTL_OFF);
        int ts[9];
#pragma unroll
        for (int e = 0; e < 9; ++e) ts[e] = __builtin_amdgcn_readfirstlane((int)(offs[e] >> 8));
        pg8::Gemm g{R1, (const bf16*)(F.ws + WS_WED), DFE, DFE, DFE, 0, (size_t)1024 * DFE * 2}; MoeOrder S{ts[8], 4, F.G, (int)blockIdx.x, ts[1], ts[2], ts[3], ts[4], ts[5], ts[6], ts[7]}; pg8::EpiBf16 E{R2, 1024};
        pg8::gemm_phase<pg8::EpiBf16, MoeOrder, true, true>(F.lds + RING_OFF, g, S, E); } SEAM(14);
    if (IN(15)) { p14_final(args, F); }
#undef IN
#undef SEAM
}

extern "C" void kernel_launch(void* const* d_in, const int* in_sizes, int n_in, void* d_out, int out_size, void* d_ws, size_t ws_size, hipStream_t stream) {
    static int grid = 0;
    if (grid == 0) {
        if (n_in != 23 || in_sizes[0] != ML * DMODEL || out_size != ML * DMODEL || ws_size < WS_END) { fprintf(stderr, "kernel_launch: unexpected shapes / workspace (n_in %d, in0 %d, out %d, ws %zu); nothing launched\n", n_in, n_in > 0 ? in_sizes[0] : -1, out_size, ws_size); grid = -1; return; }
        int dev = 0, cus = 0, per_cu = 0;
        if (hipGetDevice(&dev) != hipSuccess || hipDeviceGetAttribute(&cus, hipDeviceAttributeMultiprocessorCount, dev) != hipSuccess) { fprintf(stderr, "kernel_launch: hipGetDevice / hipDeviceGetAttribute failed; nothing launched\n"); grid = -1; return; }
        if (hipFuncSetAttribute((const void*)fwd_kernel, hipFuncAttributeMaxDynamicSharedMemorySize, LDS_BYTES) != hipSuccess) { fprintf(stderr, "kernel_launch: hipFuncSetAttribute failed; nothing launched\n"); grid = -1; return; }
        if (hipOccupancyMaxActiveBlocksPerMultiprocessor(&per_cu, (const void*)fwd_kernel, NWAVES * 64, LDS_BYTES) != hipSuccess || per_cu < 1) { fprintf(stderr, "kernel_launch: occupancy query reports %d workgroups per CU\n", per_cu); }
        (void)hipGetLastError();
        grid = cus;
    }
    if (grid < 0) return;
    if (hipMemsetAsync((char*)d_ws + WS_CTL, 0, CTL_ZERO_BYTES, stream) != hipSuccess) { fprintf(stderr, "kernel_launch: hipMemsetAsync failed\n"); return; }
    Args a{};
    for (int i = 0; i < 23; ++i) a.in[i] = (const float*)d_in[i];
    a.out = (float*)d_out; a.ws = (unsigned char*)d_ws;
#if MK_PER_PHASE
    for (int p = 0; p < NPHASE; ++p) { a.ph_lo = p; a.ph_hi = p + 1; hipLaunchKernelGGL(fwd_kernel, dim3(grid), dim3(NWAVES * 64), LDS_BYTES, stream, a); }
#else
    a.ph_lo = 0; a.ph_hi = NPHASE;
    hipLaunchKernelGGL(fwd_kernel, dim3(grid), dim3(NWAVES * 64), LDS_BYTES, stream, a);
#endif
    const hipError_t le = hipPeekAtLastError();
    if (le != hipSuccess) fprintf(stderr, "kernel_launch: launch failed: %s\n", hipGetErrorName(le));
}
```

```cpp
#define MK_PER_PHASE 0
#include <hip/hip_runtime.h>
#include <hip/hip_bf16.h>
#include <cstdio>
#include <cstdint>
#include <cmath>
namespace pg8 {
#define PG8_LAS __attribute__((address_space(3)))
typedef unsigned short bf16_t;
typedef short bf16x8 __attribute__((ext_vector_type(8)));
typedef float f32x4 __attribute__((ext_vector_type(4)));
typedef unsigned u32x4 __attribute__((ext_vector_type(4)));
constexpr int BM = 256, BK = 64, HALF = 128, HTB = HALF * BK * 2  , STAGE_BYTES = 8 * HTB, NXCD = 8, WGM = 8;

__host__ __device__ __forceinline__ int lds_byte(int r, int c) { const int st = (r >> 4) * 2 + (c >> 5), rr = r & 15, cc = c & 31, ob = rr * 64 + cc * 2; return st * 1024 + (ob ^ (((ob >> 9) & 1) << 5)); }
__host__ __device__ __forceinline__ void stage_rc(int b, int& R, int& C) { const int st = b / 1024, sb = b % 1024, swz = sb ^ (((sb >> 9) & 1) << 5); R = (st >> 1) * 16 + swz / 64; C = (st & 1) * 32 + (swz % 64) / 2; }
__host__ __device__ __forceinline__ int perm32(int rho) { const int n = rho >> 4, i = rho & 15; return 8 * (i >> 2) + 4 * n + (i & 3); }

struct Unit { int pm, pn, e, om; };
struct Gemm { const bf16_t* A; const bf16_t* Bt; int K, lda, ldb; size_t a_pn_bytes, b_e_bytes; const unsigned* rows; };

__host__ __device__ __forceinline__ void tile_map(int L, int nM, int nN, int& pm, int& pn) {
    const int nwg = nM * nN; int wgid = L; { const int q = nwg / NXCD, r = nwg % NXCD, xcd = wgid % NXCD, off = wgid / NXCD; wgid = (xcd < r ? xcd * (q + 1) : r * (q + 1) + (xcd - r) * q) + off; }
    const int nig = WGM * nN, gid = wgid / nig, fm = gid * WGM, gsz = (nM - fm) < WGM ? (nM - fm) : WGM;
    pm = fm + ((wgid % nig) % gsz); pn = (wgid % nig) / gsz;
}

template <class V> __device__ __forceinline__ void st16(void* p, const V v) { *(V*)p = v; }
__device__ __forceinline__ unsigned cvt_pk_bf16(float lo, float hi) { unsigned r; asm volatile("v_cvt_pk_bf16_f32 %0, %1, %2" : "=v"(r) : "v"(lo), "v"(hi)); return r; }

struct EpiBf16 {
    static constexpr bool PERM = true, AFTER_DRAIN = false;
    bf16_t* O; int ldc; int nostore;
    __device__ __forceinline__ void operator()(const f32x4 (&acc)[2][2][4][2], const Unit& u, int wr, int wc, int fr, int fq) const {
        const int row0 = u.om * BM + wr * 64 + fr; const int col0 = u.pn * BM + wc * 32 + 8 * fq;
#pragma unroll
        for (int ai = 0; ai < 2; ++ai)
#pragma unroll
            for (int m = 0; m < 4; ++m) { bf16_t* rowp = O + (size_t)(row0 + ai * HALF + m * 16) * ldc + col0;
#pragma unroll
                for (int bj = 0; bj < 2; ++bj) { const f32x4 v0 = acc[ai][bj][m][0], v1 = acc[ai][bj][m][1];
                    u32x4 w; w.x = cvt_pk_bf16(v0[0], v0[1]); w.y = cvt_pk_bf16(v0[2], v0[3]); w.z = cvt_pk_bf16(v1[0], v1[1]); w.w = cvt_pk_bf16(v1[2], v1[3]);
                    if (nostore) asm volatile("" :: "v"(w)); else st16(rowp + bj * HALF, w); } }
    }
};
struct EpiInProj {
    static constexpr bool PERM = true, AFTER_DRAIN = false;
    bf16_t* O; int ldc; int nostore; const float* qg; const float* kg; const float* ropeT; float qscale;
    __device__ __forceinline__ void operator()(const f32x4 (&acc)[2][2][4][2], const Unit& u, int wr, int wc, int fr, int fq) const {
        const int row0 = u.om * BM + wr * 64 + fr;
        if (u.pn < 5) { const int col0 = u.pn * BM + wc * 64 + 8 * fq;
            const bool isq = u.pn < 2, isk = u.pn == 4 && wc < 2;
            if (isq || isk) {
                const float* gp = (isq ? qg : kg) + 4 * fq; const float sc = isq ? qscale : 1.0f;
                f32x4 g[2][2];
#pragma unroll
                for (int bj = 0; bj < 2; ++bj)
#pragma unroll
                    for (int n = 0; n < 2; ++n) g[bj][n] = *(const f32x4*)(gp + bj * 32 + n * 16) * sc;
                const int tt = u.om % 33; const bool lat = tt != 0; const int t0 = (tt - 1) * BM + wr * 64 + fr;
#pragma unroll
                for (int ai = 0; ai < 2; ++ai)
#pragma unroll
                    for (int m = 0; m < 4; ++m) { bf16_t* rowp = O + (size_t)(row0 + ai * HALF + m * 16) * ldc + col0;
                        float ss = 0.f;
#pragma unroll
                        for (int bj = 0; bj < 2; ++bj)
#pragma unroll
                            for (int n = 0; n < 2; ++n) { const f32x4 v = acc[ai][bj][m][n]; ss += (v[0] * v[0] + v[1] * v[1]) + (v[2] * v[2] + v[3] * v[3]); }
                        ss += __shfl_xor(ss, 16); ss += __shfl_xor(ss, 32);
                        const float rstd = rsqrtf(ss * (1.0f / 64.0f) + 1e-6f);
                        const int t = t0 + ai * HALF + m * 16;
#pragma unroll
                        for (int bj = 0; bj < 2; ++bj) { f32x4 x1 = acc[ai][bj][m][0] * rstd * g[bj][0], x2 = acc[ai][bj][m][1] * rstd * g[bj][1];
                            if (lat) { const int pos = bj ? 128 + (t & 63) : (t >> 6); const float* tp = ropeT + ((size_t)pos * 16 + 4 * fq) * 2; const f32x4 cs0 = *(const f32x4*)tp, cs1 = *(const f32x4*)(tp + 4);
                                const f32x4 c = (f32x4){cs0[0], cs0[2], cs1[0], cs1[2]}, sn = (f32x4){cs0[1], cs0[3], cs1[1], cs1[3]};
                                const f32x4 y1 = x1 * c - x2 * sn, y2 = x2 * c + x1 * sn; x1 = y1; x2 = y2; }
                            u32x4 w; w.x = cvt_pk_bf16(x1[0], x1[1]); w.y = cvt_pk_bf16(x1[2], x1[3]); w.z = cvt_pk_bf16(x2[0], x2[1]); w.w = cvt_pk_bf16(x2[2], x2[3]);
                            if (nostore) asm volatile("" :: "v"(w)); else st16(rowp + bj * 32, w); } }
            } else {
#pragma unroll
                for (int ai = 0; ai < 2; ++ai)
#pragma unroll
                    for (int m = 0; m < 4; ++m) { bf16_t* rowp = O + (size_t)(row0 + ai * HALF + m * 16) * ldc + col0;
#pragma unroll
                        for (int bj = 0; bj < 2; ++bj) { const f32x4 v0 = acc[ai][bj][m][0], v1 = acc[ai][bj][m][1];
                            u32x4 w; w.x = cvt_pk_bf16(v0[0], v0[1]); w.y = cvt_pk_bf16(v0[2], v0[3]); w.z = cvt_pk_bf16(v1[0], v1[1]); w.w = cvt_pk_bf16(v1[2], v1[3]);
                            if (nostore) asm volatile("" :: "v"(w)); else st16(rowp + bj * 32, w); } }
            }
        } else { const int col0 = 1280 + (u.pn - 5) * HALF + wc * 32 + 8 * fq;
#pragma unroll
            for (int ai = 0; ai < 2; ++ai)
#pragma unroll
                for (int m = 0; m < 4; ++m) { bf16_t* rowp = O + (size_t)(row0 + ai * HALF + m * 16) * ldc + col0;
                    const f32x4 p0 = acc[ai][0][m][0] * acc[ai][1][m][0], p1 = acc[ai][0][m][1] * acc[ai][1][m][1];
                    u32x4 w; w.x = cvt_pk_bf16(p0[0], p0[1]); w.y = cvt_pk_bf16(p0[2], p0[3]); w.z = cvt_pk_bf16(p1[0], p1[1]); w.w = cvt_pk_bf16(p1[2], p1[3]);
                    if (nostore) asm volatile("" :: "v"(w)); else st16(rowp, w); } }
    }
};
struct EpiSwiGLU {
    static constexpr bool PERM = true, AFTER_DRAIN = false;
    bf16_t* O; int ldc; int nostore;
    __device__ __forceinline__ static f32x4 silu_mul4(const f32x4 g, const f32x4 u) { const f32x4 t = g * -1.4426950408889634f; f32x4 e; e[0] = __builtin_amdgcn_exp2f(t[0]); e[1] = __builtin_amdgcn_exp2f(t[1]); e[2] = __builtin_amdgcn_exp2f(t[2]); e[3] = __builtin_amdgcn_exp2f(t[3]);
        const f32x4 d = e + 1.0f; f32x4 r; r[0] = __builtin_amdgcn_rcpf(d[0]); r[1] = __builtin_amdgcn_rcpf(d[1]); r[2] = __builtin_amdgcn_rcpf(d[2]); r[3] = __builtin_amdgcn_rcpf(d[3]); return (g * u) * r; }
    __device__ __forceinline__ void operator()(const f32x4 (&acc)[2][2][4][2], const Unit& u, int wr, int wc, int fr, int fq) const {
        const int col0 = u.pn * HALF + wc * 32 + 8 * fq; const unsigned off0 = ((unsigned)((u.om * (ldc >> 6) + (col0 >> 6)) * BM + wr * 64 + fr) * 64u + (unsigned)(col0 & 63)) * 2u;
#pragma unroll
        for (int ai = 0; ai < 2; ++ai)
#pragma unroll
            for (int m = 0; m < 4; ++m) { bf16_t* rowp = (bf16_t*)((char*)O + (off0 + (unsigned)((ai * HALF + m * 16) * 128)));
                const f32x4 h0 = silu_mul4(acc[ai][0][m][0], acc[ai][1][m][0]), h1 = silu_mul4(acc[ai][0][m][1], acc[ai][1][m][1]);
                u32x4 w; w.x = cvt_pk_bf16(h0[0], h0[1]); w.y = cvt_pk_bf16(h0[2], h0[3]); w.z = cvt_pk_bf16(h1[0], h1[1]); w.w = cvt_pk_bf16(h1[2], h1[3]);
                if (nostore == 1) asm volatile("" :: "v"(w)); else if (nostore == 2) __builtin_nontemporal_store(w, (u32x4*)rowp); else if (nostore == 3) *(u32x4*)rowp = w; else st16(rowp, w); }
    }
};
template <bool BASE_F32> struct EpiResB {
    static constexpr bool PERM = true, AFTER_DRAIN = false;
    const void* base; bf16_t* out; const float* gate; int gate_bstride; const float* cscale; int nostore; float* ssq;
    __device__ __forceinline__ void operator()(const f32x4 (&acc)[2][2][4][2], const Unit& u, int wr, int wc, int fr, int fq) const {
        const int row0 = u.om * BM + wr * 64 + fr, col0 = u.pn * BM + wc * 32 + 8 * fq; const int b = u.om >> 5;
        f32x4 gv[2][2];
#pragma unroll
        for (int bj = 0; bj < 2; ++bj)
#pragma unroll
            for (int n = 0; n < 2; ++n) { gv[bj][n] = *(const f32x4*)(gate + (size_t)b * gate_bstride + col0 + bj * HALF + n * 4); if (cscale) gv[bj][n] = gv[bj][n] * *(const f32x4*)(cscale + col0 + bj * HALF + n * 4); }
#pragma unroll
        for (int ai = 0; ai < 2; ++ai)
#pragma unroll
            for (int m = 0; m < 4; ++m) { const size_t off = (size_t)(row0 + ai * HALF + m * 16) * 1024 + col0; float sq = 0.f;
#pragma unroll
                for (int bj = 0; bj < 2; ++bj) { f32x4 b0, b1;
                    if (BASE_F32) { b0 = *(const f32x4*)((const float*)base + off + bj * HALF); b1 = *(const f32x4*)((const float*)base + off + bj * HALF + 4); }
                    else { const u32x4 w = *(const u32x4*)((const bf16_t*)base + off + bj * HALF);
                        b0 = (f32x4){__uint_as_float(w.x << 16), __uint_as_float(w.x & 0xffff0000u), __uint_as_float(w.y << 16), __uint_as_float(w.y & 0xffff0000u)};
                        b1 = (f32x4){__uint_as_float(w.z << 16), __uint_as_float(w.z & 0xffff0000u), __uint_as_float(w.w << 16), __uint_as_float(w.w & 0xffff0000u)}; }
                    const f32x4 o0 = b0 + gv[bj][0] * acc[ai][bj][m][0], o1 = b1 + gv[bj][1] * acc[ai][bj][m][1];
                    u32x4 ow; ow.x = cvt_pk_bf16(o0[0], o0[1]); ow.y = cvt_pk_bf16(o0[2], o0[3]); ow.z = cvt_pk_bf16(o1[0], o1[1]); ow.w = cvt_pk_bf16(o1[2], o1[3]);
                    sq += (o0[0] * o0[0] + o0[1] * o0[1]) + (o0[2] * o0[2] + o0[3] * o0[3]) + (o1[0] * o1[0] + o1[1] * o1[1]) + (o1[2] * o1[2] + o1[3] * o1[3]);
                    if (nostore) asm volatile("" :: "v"(ow)); else *(u32x4*)(out + off + bj * HALF) = ow; }
                if (ssq) { sq += __shfl_xor(sq, 16); sq += __shfl_xor(sq, 32); if (fq == 0 && !nostore) ssq[(size_t)(row0 + ai * HALF + m * 16) * 16 + u.pn * 4 + wc] = sq; }
                if (BASE_F32 ? (m & 1) : (m == 3)) asm volatile("" ::: "memory"); }
    }
};
struct EpiRes {
    static constexpr bool PERM = false, AFTER_DRAIN = false;
    const float* base; float* out; const float* gate; int gate_bstride; const float* cscale; int nostore;
    __device__ __forceinline__ void operator()(const f32x4 (&acc)[2][2][4][2], const Unit& u, int wr, int wc, int fr, int fq) const {
        const int row0 = u.om * BM + wr * 64 + fr, col0 = u.pn * BM + wc * 32 + 4 * fq; const int b = u.om >> 5;
        f32x4 gv[2][2];
#pragma unroll
        for (int bj = 0; bj < 2; ++bj)
#pragma unroll
            for (int n = 0; n < 2; ++n) { gv[bj][n] = *(const f32x4*)(gate + (size_t)b * gate_bstride + col0 + bj * HALF + n * 16); if (cscale) gv[bj][n] = gv[bj][n] * *(const f32x4*)(cscale + col0 + bj * HALF + n * 16); }
#pragma unroll
        for (int ai = 0; ai < 2; ++ai)
#pragma unroll
            for (int m = 0; m < 4; ++m) { const size_t off = (size_t)(row0 + ai * HALF + m * 16) * 1024 + col0;
#pragma unroll
                for (int bj = 0; bj < 2; ++bj)
#pragma unroll
                    for (int n = 0; n < 2; ++n) { const f32x4 bs = *(const f32x4*)(base + off + bj * HALF + n * 16); const f32x4 ov = bs + gv[bj][n] * acc[ai][bj][m][n]; if (nostore) asm volatile("" :: "v"(ov)); else st16(out + off + bj * HALF + n * 16, ov); }
                if (m & 1) asm volatile("" ::: "memory"); }
    }
};
template <class Epi, class Sched, bool ALIGN_EPI = false, bool SP2 = false, bool ATILED = false, bool AGATHER = false>
__device__ __forceinline__ void gemm_phase(PG8_LAS unsigned char* lds, const Gemm g, const Sched& S, const Epi& E) {
    const int tid = threadIdx.x, wid = __builtin_amdgcn_readfirstlane(tid >> 6), lane = tid & 63, wr = wid >> 2, wc = wid & 3, fr = lane & 15, fq = lane >> 4;
    const int K = g.K, nt = K / BK;
    unsigned voffA[2], voffB[2];
#pragma unroll
    for (int i = 0; i < 2; ++i) { int R, C; stage_rc(tid * 16 + i * 8192, R, C); const int Rb = Epi::PERM ? ((R & ~31) + perm32(R & 31)) : R;
        voffA[i] = (unsigned)(R * (ATILED ? 64 : g.lda) + C) * 2u; voffB[i] = (unsigned)(Rb * g.ldb + C) * 2u; }
    unsigned vA0[2], vA1[2], vN0[2], vN1[2];
#pragma unroll
    for (int i = 0; i < 2; ++i) { vA0[i] = voffA[i]; vA1[i] = voffA[i]; vN0[i] = voffA[i]; vN1[i] = voffA[i]; }
#define PG8_GATHER(dst0, dst1, pm_) do { if constexpr (AGATHER) { _Pragma("unroll") for (int _i = 0; _i < 2; ++_i) { int R_, C_; stage_rc(tid * 16 + _i * 8192, R_, C_); \
        dst0[_i] = (g.rows[(size_t)(pm_) * BM + R_] * (unsigned)g.lda + (unsigned)C_) * 2u; dst1[_i] = (g.rows[(size_t)(pm_) * BM + HALF + R_] * (unsigned)g.lda + (unsigned)C_) * 2u; } } } while (0)
    const size_t kstepB = (size_t)(BK * 2), kstepA = ATILED ? (size_t)32768 : kstepB;
    const size_t hstepA = AGATHER ? (size_t)0 : (size_t)HALF * (ATILED ? 64 : g.lda) * 2, hstepB = (size_t)HALF * g.ldb * 2;
    const size_t tstepA = AGATHER ? (size_t)0 : ATILED ? (size_t)(K / BK) * 32768 : 2 * hstepA, tstepB = 2 * hstepB;
    const unsigned ldsw = (unsigned)wid * 1024u;
    const int aoff = lds_byte(wr * 64 + fr, fq * 8), boff = lds_byte(wc * 32 + fr, fq * 8);
#define PG8_SA(b, h) (((b) * 2 + (h)) * HTB)
#define PG8_SB(b, h) ((4 + (b) * 2 + (h)) * HTB)
#define PG8_STAGE(bufoff, gbase, voff) do { _Pragma("unroll") for (int _i = 0; _i < 2; ++_i) \
        __builtin_amdgcn_global_load_lds((const unsigned*)((const char*)(gbase) + (voff)[_i]), (PG8_LAS unsigned*)(lds + (bufoff) + ldsw + _i * 8192), 16, 0, 0); } while (0)
#define PG8_STAGE_A(bufoff, gbase, h, nx) do { _Pragma("unroll") for (int _i = 0; _i < 2; ++_i) \
        __builtin_amdgcn_global_load_lds((const unsigned*)((const char*)(gbase) + ((nx) ? ((h) ? vN1[_i] : vN0[_i]) : ((h) ? vA1[_i] : vA0[_i]))), (PG8_LAS unsigned*)(lds + (bufoff) + ldsw + _i * 8192), 16, 0, 0); } while (0)
#define PG8_LDA(dst, b, h) do { _Pragma("unroll") for (int m = 0; m < 4; ++m) _Pragma("unroll") for (int k = 0; k < 2; ++k) dst[m][k] = *(const PG8_LAS bf16x8*)(lds + PG8_SA(b, h) + aoff + m * 2048 + k * 1024); } while (0)
#define PG8_LDB(dst, b, h) do { _Pragma("unroll") for (int n = 0; n < 2; ++n) _Pragma("unroll") for (int k = 0; k < 2; ++k) dst[n][k] = *(const PG8_LAS bf16x8*)(lds + PG8_SB(b, h) + boff + n * 2048 + k * 1024); } while (0)
#define PG8_MMA(ai, bj, At, Bt) do { __builtin_amdgcn_s_setprio(1); _Pragma("unroll") for (int m = 0; m < 4; ++m) _Pragma("unroll") for (int n = 0; n < 2; ++n) _Pragma("unroll") for (int k = 0; k < 2; ++k) \
        acc[ai][bj][m][n] = __builtin_amdgcn_mfma_f32_16x16x32_bf16(Bt[n][k], At[m][k], acc[ai][bj][m][n], 0, 0, 0); __builtin_amdgcn_s_setprio(0); } while (0)
#define PG8_WAIT_V(n) asm volatile("s_waitcnt vmcnt(" #n ")" ::: "memory")
#define PG8_WAIT_L(n) asm volatile("s_waitcnt lgkmcnt(" #n ")" ::: "memory")
#define PG8_BAR __builtin_amdgcn_s_barrier()
#define PG8_SCHED __builtin_amdgcn_sched_barrier(0)
    Unit cur, nxt; int ui = 0;
    if (!S.next(0, cur)) return;
    f32x4 acc[2][2][4][2];
#pragma unroll
    for (int a = 0; a < 2; ++a)
#pragma unroll
        for (int b = 0; b < 2; ++b)
#pragma unroll
            for (int m = 0; m < 4; ++m)
#pragma unroll
                for (int n = 0; n < 2; ++n) acc[a][b][m][n] = (f32x4){0.f, 0.f, 0.f, 0.f};
    bf16x8 At[4][2], B0[2][2], B1[2][2];
    const char* cA = (const char*)g.A + (size_t)cur.pm * tstepA + (size_t)cur.pn * g.a_pn_bytes; const char* cB = (const char*)g.Bt + (size_t)cur.pn * tstepB + (size_t)cur.e * g.b_e_bytes;
    PG8_GATHER(vA0, vA1, cur.pm);
    S.a_ready(cur);
    if constexpr (SP2) {
        PG8_STAGE(PG8_SB(0, 0), cB, voffB); PG8_STAGE(PG8_SB(0, 1), cB + hstepB, voffB); PG8_STAGE_A(PG8_SA(0, 0), cA, 0, false); PG8_STAGE_A(PG8_SA(0, 1), cA + hstepA, 1, false);
        if (wr == 1) PG8_BAR;
        PG8_WAIT_V(2); PG8_BAR;
        PG8_STAGE(PG8_SB(1, 0), cB + kstepB, voffB); PG8_STAGE_A(PG8_SA(1, 0), cA + kstepA, 0, false); PG8_STAGE(PG8_SB(1, 1), cB + hstepB + kstepB, voffB);
        PG8_WAIT_V(6); PG8_BAR;
    } else {
        PG8_STAGE(PG8_SB(0, 0), cB, voffB); PG8_STAGE_A(PG8_SA(0, 0), cA, 0, false); PG8_STAGE(PG8_SB(0, 1), cB + hstepB, voffB); PG8_STAGE_A(PG8_SA(0, 1), cA + hstepA, 1, false);
        if (wr == 1) PG8_BAR;
        PG8_WAIT_V(4); PG8_BAR;
        PG8_STAGE(PG8_SB(1, 0), cB + kstepB, voffB); PG8_STAGE_A(PG8_SA(1, 0), cA + kstepA, 0, false); PG8_STAGE(PG8_SB(1, 1), cB + hstepB + kstepB, voffB);
        PG8_WAIT_V(6); PG8_BAR;
    }
    for (;;) {
        const bool has_next = S.next(ui + 1, nxt);
        if (has_next) PG8_GATHER(vN0, vN1, nxt.pm); else { _Pragma("unroll") for (int i = 0; i < 2; ++i) { vN0[i] = vA0[i]; vN1[i] = vA1[i]; } }
        const char* nA = has_next ? (const char*)g.A + (size_t)nxt.pm * tstepA + (size_t)nxt.pn * g.a_pn_bytes : cA; const char* nB = has_next ? (const char*)g.Bt + (size_t)nxt.pn * tstepB + (size_t)nxt.e * g.b_e_bytes : cB;
#pragma unroll 1
        for (int t = 0; t < nt; t += 2) {
            const bool last = (t == nt - 2);
            const char* a1 = cA + (size_t)(t + 1) * kstepA;
            const char* a2 = last ? nA : cA + (size_t)(t + 2) * kstepA; const char* b2 = last ? nB : cB + (size_t)(t + 2) * kstepB;
            const char* a3 = a2 + kstepA; const char* b3 = b2 + kstepB;
            if (last && has_next) S.a_ready(nxt);
            if constexpr (SP2) {
            PG8_LDB(B0, 0, 0); PG8_LDB(B1, 0, 1); PG8_SCHED; PG8_LDA(At, 0, 0); PG8_STAGE_A(PG8_SA(1, 1), a1 + hstepA, 1, false);
            PG8_WAIT_V(8); PG8_WAIT_L(0); PG8_BAR; PG8_MMA(0, 0, At, B0); PG8_MMA(0, 1, At, B1); PG8_BAR; PG8_SCHED;
            PG8_LDA(At, 0, 1); PG8_STAGE(PG8_SB(0, 0), b2, voffB); PG8_STAGE(PG8_SB(0, 1), b2 + hstepB, voffB); PG8_STAGE_A(PG8_SA(0, 0), a2, 0, last);
            PG8_WAIT_V(8); PG8_WAIT_L(0); PG8_BAR; PG8_MMA(1, 0, At, B0); PG8_MMA(1, 1, At, B1); PG8_BAR; PG8_SCHED;
            PG8_LDB(B0, 1, 0); PG8_LDB(B1, 1, 1); PG8_SCHED; PG8_LDA(At, 1, 0); PG8_STAGE_A(PG8_SA(0, 1), a2 + hstepA, 1, last);
            PG8_WAIT_V(8); PG8_WAIT_L(0); PG8_BAR; PG8_MMA(0, 0, At, B0); PG8_MMA(0, 1, At, B1); PG8_BAR; PG8_SCHED;
            PG8_LDA(At, 1, 1); PG8_STAGE(PG8_SB(1, 0), b3, voffB); PG8_STAGE(PG8_SB(1, 1), b3 + hstepB, voffB); PG8_STAGE_A(PG8_SA(1, 0), a3, 0, last);
            PG8_WAIT_V(8); PG8_WAIT_L(0); PG8_BAR; PG8_MMA(1, 0, At, B0); PG8_MMA(1, 1, At, B1); PG8_BAR; PG8_SCHED;
            } else {
            PG8_LDB(B0, 0, 0); PG8_SCHED; PG8_LDA(At, 0, 0); PG8_STAGE_A(PG8_SA(1, 1), a1 + hstepA, 1, false);
            PG8_WAIT_L(8); PG8_BAR; PG8_WAIT_L(0); PG8_MMA(0, 0, At, B0); PG8_BAR; PG8_SCHED;
            PG8_LDB(B1, 0, 1); PG8_STAGE(PG8_SB(0, 0), b2, voffB);
            PG8_BAR; PG8_WAIT_L(0); PG8_MMA(0, 1, At, B1); PG8_BAR;
            PG8_LDA(At, 0, 1); PG8_STAGE_A(PG8_SA(0, 0), a2, 0, last);
            PG8_BAR; PG8_WAIT_L(0); PG8_MMA(1, 0, At, B0); PG8_BAR; PG8_SCHED;
            PG8_STAGE(PG8_SB(0, 1), b2 + hstepB, voffB);
            PG8_WAIT_V(6); PG8_BAR; PG8_MMA(1, 1, At, B1); PG8_BAR;
            PG8_LDB(B0, 1, 0); PG8_SCHED; PG8_LDA(At, 1, 0); PG8_STAGE_A(PG8_SA(0, 1), a2 + hstepA, 1, last);
            PG8_WAIT_L(8); PG8_BAR; PG8_WAIT_L(0); PG8_MMA(0, 0, At, B0); PG8_BAR; PG8_SCHED;
            PG8_LDB(B1, 1, 1); PG8_STAGE(PG8_SB(1, 0), b3, voffB);
            PG8_BAR; PG8_WAIT_L(0); PG8_MMA(0, 1, At, B1); PG8_BAR;
            PG8_LDA(At, 1, 1); PG8_STAGE_A(PG8_SA(1, 0), a3, 0, last);
            PG8_BAR; PG8_WAIT_L(0); PG8_MMA(1, 0, At, B0); PG8_BAR; PG8_SCHED;
            PG8_STAGE(PG8_SB(1, 1), b3 + hstepB, voffB);
            PG8_WAIT_V(6); PG8_BAR; PG8_MMA(1, 1, At, B1); PG8_BAR;
            }
        }
        if constexpr (ALIGN_EPI) { if (wr == 0) PG8_BAR; }
        if constexpr (!Epi::AFTER_DRAIN) { E(acc, cur, wr, wc, fr, fq); S.done(cur); }
        if (!has_next) break;
#pragma unroll
        for (int a = 0; a < 2; ++a)
#pragma unroll
            for (int b = 0; b < 2; ++b)
#pragma unroll
                for (int m = 0; m < 4; ++m)
#pragma unroll
                    for (int n = 0; n < 2; ++n) acc[a][b][m][n] = (f32x4){0.f, 0.f, 0.f, 0.f};
        cur = nxt; cA = nA; cB = nB; ++ui;
#pragma unroll
        for (int i = 0; i < 2; ++i) { vA0[i] = vN0[i]; vA1[i] = vN1[i]; }
        if constexpr (ALIGN_EPI) { if (wr == 1) PG8_BAR; }
    }
    PG8_WAIT_V(0);
    if constexpr (!ALIGN_EPI) { if (wr == 0) PG8_BAR; }
    PG8_BAR;
    if constexpr (Epi::AFTER_DRAIN) { E.fused(acc, cur, wr, wc, fr, fq, lds, wid, lane); S.done(cur); }
#undef PG8_SA
#undef PG8_SB
#undef PG8_STAGE
#undef PG8_STAGE_A
#undef PG8_GATHER
#undef PG8_LDA
#undef PG8_LDB
#undef PG8_MMA
#undef PG8_WAIT_V
#undef PG8_WAIT_L
#undef PG8_BAR
#undef PG8_SCHED
}
}
#include <hip/hip_bf16.h>
#include <cmath>
namespace attn_body {
using bf16=__hip_bfloat16;
using bf16x8=__attribute__((ext_vector_type(8)))short;
using s16x4=__attribute__((ext_vector_type(4)))short;
using f32x16=__attribute__((ext_vector_type(16)))float;
using u32x4=__attribute__((ext_vector_type(4)))unsigned;
constexpr int D=64,DM=2304,SKV=8448,SCTX=256;
constexpr int NW=8,QBLK=32,QB=QBLK*NW,KVBLK=64,NQB=32;
constexpr int ATTN_PITCH=DM, ATTN_UNIT_ROWS=QB;
__device__ __forceinline__ int crow(int r,int hi){return (r&3)+8*(r>>2)+4*hi;}
#define SBAR() __builtin_amdgcn_sched_barrier(0)
__device__ __forceinline__ void cmask(f32x16&p0,f32x16&p1,int jb,int qrel,int hi){
  const float NEG=-INFINITY; int kb=64*jb+4*hi;
  #pragma unroll
  for(int r=0;r<16;++r){int kv=kb+(r&3)+8*(r>>2); if(kv>qrel)p0[r]=NEG; if(kv+32>qrel)p1[r]=NEG;}
}

constexpr int NSLOT=3, SLOTB=8192;
constexpr int LDS_K=0, LDS_V=NSLOT*SLOTB, LDS_WS=2*NSLOT*SLOTB, LDS_OST=LDS_WS+NW*64*4, LDS_BYTES=LDS_OST+NW*4096;
constexpr float C2=0.125f*1.4426950408889634f;
__device__ __forceinline__ void glds16(const void*gsrc,unsigned lds_dst){unsigned keep;
  asm volatile("s_mov_b32 %0, m0\n\ts_mov_b32 m0, %2\n\ts_nop 0\n\tglobal_load_lds_dwordx4 %1, off\n\ts_mov_b32 m0, %0":"=&s"(keep):"v"(gsrc),"s"(lds_dst):"memory");}
__device__ __forceinline__ float max3f(float a,float b,float c){float r;asm("v_max3_f32 %0, %1, %2, %3":"=v"(r):"v"(a),"v"(b),"v"(c));return r;}
__device__ __forceinline__ float max2f(float a,float b){float r;asm("v_max_f32_e32 %0, %1, %2":"=v"(r):"v"(a),"v"(b));return r;}
__device__ __forceinline__ float fadd_s(float a,float b){float r;asm("v_add_f32_e32 %0, %1, %2":"=v"(r):"v"(a),"v"(b));return r;}
__device__ __forceinline__ float fsub_s(float a,float b){float r;asm("v_sub_f32_e32 %0, %1, %2":"=v"(r):"v"(a),"v"(b));return r;}
typedef float f32x2_t __attribute__((ext_vector_type(2))); typedef __bf16 bf16x2_t __attribute__((ext_vector_type(2)));
__device__ __forceinline__ unsigned cvtpk_s(float lo,float hi){f32x2_t v={lo,hi};bf16x2_t b=__builtin_convertvector(v,bf16x2_t);return __builtin_bit_cast(unsigned,b);}
#define WAIT_BAR(N) asm volatile("s_waitcnt vmcnt(" #N ") lgkmcnt(0)\n\ts_barrier":::"memory")

__device__ __forceinline__ void qkt(f32x16&p0,f32x16&p1,const char*Kslot,const bf16x8*qr,const f32x16&negm,int r32,int hi){
  const char*kb=Kslot+hi*1024+r32*16;
  #pragma unroll
  for(int d0=0;d0<4;++d0){
    const bf16x8 b0=*reinterpret_cast<const bf16x8*>(kb+d0*2048);
    const bf16x8 b1=*reinterpret_cast<const bf16x8*>(kb+d0*2048+512);
    if(d0==0){p0=__builtin_amdgcn_mfma_f32_32x32x16_bf16(b0,qr[0],negm,0,0,0);p1=__builtin_amdgcn_mfma_f32_32x32x16_bf16(b1,qr[0],negm,0,0,0);}
    else{p0=__builtin_amdgcn_mfma_f32_32x32x16_bf16(b0,qr[d0],p0,0,0,0);p1=__builtin_amdgcn_mfma_f32_32x32x16_bf16(b1,qr[d0],p1,0,0,0);}}
}
typedef __attribute__((address_space(3))) const char* lds_cptr;
typedef short v4i16_t __attribute__((ext_vector_type(4)));
__device__ __forceinline__ void kload8(bf16x8*kf,lds_cptr kp){
  kf[0]=*(const __attribute__((address_space(3))) bf16x8*)(kp);      kf[1]=*(const __attribute__((address_space(3))) bf16x8*)(kp+512);
  kf[2]=*(const __attribute__((address_space(3))) bf16x8*)(kp+2048); kf[3]=*(const __attribute__((address_space(3))) bf16x8*)(kp+2560);
  kf[4]=*(const __attribute__((address_space(3))) bf16x8*)(kp+4096); kf[5]=*(const __attribute__((address_space(3))) bf16x8*)(kp+4608);
  kf[6]=*(const __attribute__((address_space(3))) bf16x8*)(kp+6144); kf[7]=*(const __attribute__((address_space(3))) bf16x8*)(kp+6656);
}
__device__ __forceinline__ void kload2(bf16x8*kf,lds_cptr kp,int j){ kf[2*j]=*(const __attribute__((address_space(3))) bf16x8*)(kp+j*2048); kf[2*j+1]=*(const __attribute__((address_space(3))) bf16x8*)(kp+j*2048+512); }
__device__ __forceinline__ s16x4 vtr(lds_cptr p){ return __builtin_bit_cast(s16x4,__builtin_amdgcn_ds_read_tr16_b64_v4i16((__attribute__((address_space(3))) v4i16_t*)p)); }
__device__ __forceinline__ float rowmax(const f32x16&p0,const f32x16&p1){
  float a=max3f(p0[0],p0[1],p1[0]),b=max3f(p0[2],p0[3],p1[1]);a=max3f(a,p1[2],p1[3]);
  #pragma unroll
  for(int r=4;r<16;r+=4){a=max3f(a,p0[r],p0[r+1]);b=max3f(b,p0[r+2],p0[r+3]);a=max3f(a,p1[r],p1[r+1]);b=max3f(b,p1[r+2],p1[r+3]);}
  const float m=max2f(a,b);
  auto rr=__builtin_amdgcn_permlane32_swap(__float_as_uint(m),__float_as_uint(m),false,false);
  return max2f(__uint_as_float(rr[0]),__uint_as_float(rr[1]));
}
__device__ __forceinline__ void pv(f32x16*o,int vb,bf16x8 pa0,bf16x8 pa1,bf16x8 pa2,bf16x8 pa3){
  #pragma unroll
  for(int d0=0;d0<2;++d0){s16x4 lo[4],hi[4];
    #pragma unroll
    for(int ks=0;ks<4;++ks){
      asm volatile("ds_read_b64_tr_b16 %0,%1 offset:%c2":"=&v"(lo[ks]):"v"(vb),"i"(d0*4096+ks*1024):"memory");
      asm volatile("ds_read_b64_tr_b16 %0,%1 offset:%c2":"=&v"(hi[ks]):"v"(vb),"i"(d0*4096+ks*1024+512):"memory");}
    asm volatile("s_waitcnt lgkmcnt(0)":::"memory");SBAR();
    #define PK(k) (bf16x8){lo[k][0],lo[k][1],lo[k][2],lo[k][3],hi[k][0],hi[k][1],hi[k][2],hi[k][3]}
    o[d0]=__builtin_amdgcn_mfma_f32_32x32x16_bf16(pa0,PK(0),o[d0],0,0,0);
    o[d0]=__builtin_amdgcn_mfma_f32_32x32x16_bf16(pa1,PK(1),o[d0],0,0,0);
    o[d0]=__builtin_amdgcn_mfma_f32_32x32x16_bf16(pa2,PK(2),o[d0],0,0,0);
    o[d0]=__builtin_amdgcn_mfma_f32_32x32x16_bf16(pa3,PK(3),o[d0],0,0,0);
    #undef PK
  }
}

#ifndef ATTN_STORE16
#define ATTN_STORE16(p,v) (*(u32x4*)(p)=(v))
#endif
template<int THRL,bool FIXREF,int NTP> __device__ __forceinline__ void attn_unit(int b,int h,int q0,const bf16*Q,const bf16*__restrict__ K,const bf16*__restrict__ V,bf16*O,char*shm,float smax,const float*qg,const float*ropeT){
  int tid_=threadIdx.x; asm volatile("":"+v"(tid_)); const int tid=tid_,lane=tid&63,r32=lane&31,hi=lane>>5; const int wid=__builtin_amdgcn_readfirstlane(tid>>6);
  const long rowbase=(long)b*SKV; const int kvh=h>>2;
  const bf16*Qw=Q+(rowbase+q0+wid*QBLK)*DM+h*D;
  const bf16*Kh=K+rowbase*DM+kvh*D,*Vh=V+rowbase*DM+kvh*D;
  const unsigned lds0=(unsigned)(uintptr_t)shm;
  float*wsf=(float*)(shm+LDS_WS)+wid*64;
  const bf16*ksrc=Kh+(long)lane*DM+wid*8;
  const bf16*vsrc=Vh+(long)(16*(wid&3)+(lane>>2))*DM+(wid>>2)*32+(lane&3)*8;
  const unsigned kdst=lds0+LDS_K+wid*1024, vdst=lds0+LDS_V+wid*1024;
  #define DMA_K(t,slot) glds16(ksrc+(long)(t)*KVBLK*DM,(unsigned)__builtin_amdgcn_readfirstlane(kdst+(slot)))
  #define DMA_V(t,slot) glds16(vsrc+(long)(t)*KVBLK*DM,(unsigned)__builtin_amdgcn_readfirstlane(vdst+(slot)))
  const int vb0=(int)(lds0+LDS_V)+((lane>>4)&1)*32+(lane&3)*8+(4*hi+((lane&15)>>2))*64;
  const char*Kbase=shm+LDS_K; bf16x8 kf[8];
  const lds_cptr shm3=(lds_cptr)shm; const lds_cptr kp0=shm3+LDS_K+hi*1024+r32*16; const lds_cptr vp0=shm3+LDS_V+((lane>>4)&1)*32+(lane&3)*8+(4*hi+((lane&15)>>2))*64;
  constexpr int NT=NTP;
  DMA_K(0,0);DMA_V(0,0);DMA_K(1,SLOTB);
  bf16x8 qr[4];
  #pragma unroll
  for(int d0=0;d0<4;++d0)qr[d0]=*reinterpret_cast<const bf16x8*>(&Qw[(long)r32*DM+d0*16+hi*8]);
  float mhat=0.f,l_reg=0.f;f32x16 o[2];o[0]=f32x16{};o[1]=f32x16{};f32x16 negm=f32x16{}; if(FIXREF){ _Pragma("unroll") for(int r=0;r<16;++r)negm[r]=-smax; } asm volatile("":"+v"(negm));
  const int qrel=wid*QBLK+r32;
  #define CMASK(P0,P1,t) do{}while(0)
  bool resc=false;
  #define START(P0,P1) do{ if constexpr(!FIXREF){ const float rm=rowmax(P0,P1); resc=false; \
    { const float dl=rm; mhat=fadd_s(mhat,dl); \
      _Pragma("unroll") for(int r=0;r<16;++r){P0[r]=fsub_s(P0[r],dl);P1[r]=fsub_s(P1[r],dl);} \
      _Pragma("unroll") for(int r=0;r<16;++r)negm[r]=-mhat; asm volatile("":"+v"(negm)); } } \
    _Pragma("unroll") for(int r=0;r<16;++r)P0[r]=__builtin_amdgcn_exp2f(P0[r]); }while(0)
  #define RESC() do{ if constexpr(!FIXREF) if(resc){ asm volatile("s_waitcnt lgkmcnt(0)":::"memory"); \
      _Pragma("unroll") for(int d_=0;d_<2;++d_) _Pragma("unroll") for(int r=0;r<16;++r)o[d_][r]*=wsf[crow(r,hi)]; } }while(0)
  f32x16 pA0,pA1,pB0,pB1;
  int sl_prev=0,sl_cur=0,sl_next=SLOTB;
  #define ROT() do{sl_prev=sl_cur;sl_cur=sl_next;sl_next=(sl_next==(NSLOT-1)*SLOTB)?0:sl_next+SLOTB;}while(0)
  DMA_K(2,2*SLOTB);
  WAIT_BAR(3);
  qkt(pA0,pA1,Kbase,qr,negm,r32,hi);asm volatile("s_nop 15\n\ts_nop 7":"+v"(pA0),"+v"(pA1));CMASK(pA0,pA1,0);
  START(pA0,pA1);
  _Pragma("unroll") for(int r=0;r<16;++r)pA1[r]=__builtin_amdgcn_exp2f(pA1[r]);
  WAIT_BAR(0);
  DMA_K(3,0);DMA_V(1,SLOTB);
  ROT();
  kload8(kf,kp0+sl_cur);
  WAIT_BAR(2);
  s16x4 vlo[8],vhi[8]; u32x4 pw0,pw1,pw2,pw3;
  #define PKW(P,B) cvtpk_s(P[B],P[B+1])
  #define PAF(k) __builtin_bit_cast(bf16x8,pw##k)
  #define VFR(i) (bf16x8){vlo[i][0],vlo[i][1],vlo[i][2],vlo[i][3],vhi[i][0],vhi[i][1],vhi[i][2],vhi[i][3]}
  #define PIN(x) asm volatile("":"+v"(x))
  #define MX3(a,b,c) __builtin_fmaxf(__builtin_fmaxf((a),(b)),(c))
  #define GAPA(MF,A0,A1,A2,A3,W0,W1,PW) do{ MF; sacc+=A0; sacc+=A1; sacc+=A2; sacc+=A3; PIN(sacc); W0; W1; PIN(PW); SBAR(); }while(0)
  #define EX(v) __builtin_amdgcn_exp2f(v)
  #define GAPB(MF,X,B) do{ MF; X[B]=EX(X[B]); X[B+1]=EX(X[B+1]); X[B+2]=EX(X[B+2]); X[B+3]=EX(X[B+3]); PIN(X); SBAR(); }while(0)
  #define VRD(i) do{ vlo[i]=vtr(vp_+(((i)>>2)*4096+((i)&3)*1024)); vhi[i]=vtr(vp_+(((i)>>2)*4096+((i)&3)*1024+512)); }while(0)
  #define KRD(G,j) do{ if(G){ kload2(kf,kp0+sl_next,j); SBAR(); } }while(0)
  #define STEP(C0,C1,P0,P1,t,GK,GV,GL) do{ SBAR(); \
    const lds_cptr vp_=vp0+sl_prev; \
    VRD(0); SBAR(); float sacc=(P0[0]+P0[1]); \
    GAPA(C0=__builtin_amdgcn_mfma_f32_32x32x16_bf16(kf[0],qr[0],negm,0,0,0), P0[2],P0[3],P0[4],P0[5],     pw0[0]=PKW(P0,0), pw0[1]=PKW(P0,2), pw0); \
    VRD(4); SBAR(); GAPA(C1=__builtin_amdgcn_mfma_f32_32x32x16_bf16(kf[1],qr[0],negm,0,0,0), P0[6],P0[7],P0[8],P0[9],     pw0[2]=PKW(P0,4), pw0[3]=PKW(P0,6), pw0); \
    VRD(1); SBAR(); GAPA(C0=__builtin_amdgcn_mfma_f32_32x32x16_bf16(kf[2],qr[1],C0,0,0,0),   P0[10],P0[11],P0[12],P0[13], pw1[0]=PKW(P0,8), pw1[1]=PKW(P0,10), pw1); \
    VRD(5); SBAR(); GAPA(C1=__builtin_amdgcn_mfma_f32_32x32x16_bf16(kf[3],qr[1],C1,0,0,0),   P0[14],P0[15],P1[0],P1[1],   pw1[2]=PKW(P0,12),pw1[3]=PKW(P0,14), pw1); \
    VRD(2); SBAR(); GAPA(C0=__builtin_amdgcn_mfma_f32_32x32x16_bf16(kf[4],qr[2],C0,0,0,0),   P1[2],P1[3],P1[4],P1[5],     pw2[0]=PKW(P1,0), pw2[1]=PKW(P1,2), pw2); \
    VRD(6); SBAR(); GAPA(C1=__builtin_amdgcn_mfma_f32_32x32x16_bf16(kf[5],qr[2],C1,0,0,0),   P1[6],P1[7],P1[8],P1[9],     pw2[2]=PKW(P1,4), pw2[3]=PKW(P1,6), pw2); \
    VRD(3); SBAR(); GAPA(C0=__builtin_amdgcn_mfma_f32_32x32x16_bf16(kf[6],qr[3],C0,0,0,0),   P1[10],P1[11],P1[12],P1[13], pw3[0]=PKW(P1,8), pw3[1]=PKW(P1,10), pw3); \
    VRD(7); SBAR(); GAPA(C1=__builtin_amdgcn_mfma_f32_32x32x16_bf16(kf[7],qr[3],C1,0,0,0),   P1[14],P1[15],0.f,0.f,       pw3[2]=PKW(P1,12),pw3[3]=PKW(P1,14), pw3); \
    l_reg+=sacc; \
    if(GK){DMA_K((t)+3,sl_cur);} if(GV){DMA_V((t)+1,sl_next);} \
    CMASK(C0,C1,t); \
    if constexpr(!FIXREF){ float a=MX3(C0[0],C0[1],C1[0]),b=MX3(C0[2],C0[3],C1[1]); a=MX3(a,C1[2],C1[3]); \
      _Pragma("unroll") for(int r=4;r<16;r+=4){a=MX3(a,C0[r],C0[r+1]);b=MX3(b,C0[r+2],C0[r+3]);a=MX3(a,C1[r],C1[r+1]);b=MX3(b,C1[r+2],C1[r+3]);} \
      float rm=__builtin_fmaxf(a,b); { auto rr=__builtin_amdgcn_permlane32_swap(__float_as_uint(rm),__float_as_uint(rm),false,false); rm=__builtin_fmaxf(__uint_as_float(rr[0]),__uint_as_float(rr[1])); } \
      resc=false; \
      if(__builtin_expect(__any(rm>(float)THRL),0)){ const float dl=__builtin_fmaxf(rm,0.f); mhat+=dl; \
        _Pragma("unroll") for(int r=0;r<16;++r){C0[r]-=dl;C1[r]-=dl;} \
        _Pragma("unroll") for(int r=0;r<16;++r)negm[r]=-mhat; asm volatile("":"+v"(negm)); \
        const float f=__builtin_amdgcn_exp2f(-dl); l_reg*=f; if(hi==0)wsf[r32]=f; resc=true; } } \
    SBAR(); \
    GAPB(o[0]=__builtin_amdgcn_mfma_f32_32x32x16_bf16(PAF(0),VFR(0),o[0],0,0,0), C0,0); \
    GAPB(o[1]=__builtin_amdgcn_mfma_f32_32x32x16_bf16(PAF(0),VFR(4),o[1],0,0,0), C0,4); \
    KRD(GL,0); GAPB(o[0]=__builtin_amdgcn_mfma_f32_32x32x16_bf16(PAF(1),VFR(1),o[0],0,0,0), C0,8); \
    KRD(GL,1); GAPB(o[1]=__builtin_amdgcn_mfma_f32_32x32x16_bf16(PAF(1),VFR(5),o[1],0,0,0), C0,12); \
    KRD(GL,2); GAPB(o[0]=__builtin_amdgcn_mfma_f32_32x32x16_bf16(PAF(2),VFR(2),o[0],0,0,0), C1,0); \
    KRD(GL,3); GAPB(o[1]=__builtin_amdgcn_mfma_f32_32x32x16_bf16(PAF(2),VFR(6),o[1],0,0,0), C1,4); \
    GAPB(o[0]=__builtin_amdgcn_mfma_f32_32x32x16_bf16(PAF(3),VFR(3),o[0],0,0,0), C1,8); \
    GAPB(o[1]=__builtin_amdgcn_mfma_f32_32x32x16_bf16(PAF(3),VFR(7),o[1],0,0,0), C1,12); \
    }while(0)
  int t=1;
  for(;t+5<NT;t+=2){
    STEP(pB0,pB1,pA0,pA1,t,true,true,true);     WAIT_BAR(2); RESC(); ROT();
    STEP(pA0,pA1,pB0,pB1,t+1,true,true,true);   WAIT_BAR(2); RESC(); ROT();
  }
  #define ENDW(tt) do{ if((tt)+3<NT){WAIT_BAR(2);} else if((tt)+2<NT){WAIT_BAR(1);} else {WAIT_BAR(0);} }while(0)
  for(;t+1<NT;t+=2){
    STEP(pB0,pB1,pA0,pA1,t,(t+3<NT),(t+1<NT),(t+1<NT));       ENDW(t);   RESC(); ROT();
    STEP(pA0,pA1,pB0,pB1,t+1,(t+4<NT),(t+2<NT),(t+2<NT));     ENDW(t+1); RESC(); ROT();
  }
  STEP(pB0,pB1,pA0,pA1,NT-1,false,false,false); RESC();
  { float sacc=pB0[0]+pB0[1]; _Pragma("unroll") for(int r=2;r<16;++r)sacc+=pB0[r]; _Pragma("unroll") for(int r=0;r<16;++r)sacc+=pB1[r]; l_reg+=sacc;
    pw0=(u32x4){PKW(pB0,0),PKW(pB0,2),PKW(pB0,4),PKW(pB0,6)};pw1=(u32x4){PKW(pB0,8),PKW(pB0,10),PKW(pB0,12),PKW(pB0,14)};pw2=(u32x4){PKW(pB1,0),PKW(pB1,2),PKW(pB1,4),PKW(pB1,6)};pw3=(u32x4){PKW(pB1,8),PKW(pB1,10),PKW(pB1,12),PKW(pB1,14)};
    SBAR(); pv(o,vb0+sl_cur,PAF(0),PAF(1),PAF(2),PAF(3)); }
  #undef PKW
  #undef PAF
  #undef VFR
  #undef PIN
  #undef MX3
  #undef GAPA
  #undef GAPB
  #undef EX
  #undef VRD
  #undef KRD
  #undef STEP
  #undef ENDW
  {auto rr=__builtin_amdgcn_permlane32_swap(__float_as_uint(l_reg),__float_as_uint(l_reg),false,false);l_reg=__uint_as_float(rr[0])+__uint_as_float(rr[1]);}
  if(hi==0)wsf[32+r32]=l_reg;asm volatile("s_waitcnt lgkmcnt(0)":::"memory");
  float rli[16];
  #pragma unroll
  for(int r=0;r<16;++r)rli[r]=__builtin_amdgcn_rcpf(wsf[32+crow(r,hi)]);
  bf16*Ow=O+(rowbase+q0+wid*QBLK)*DM+h*D;
  { bf16*stg=(bf16*)(shm+LDS_OST)+wid*2048;
    #pragma unroll
    for(int r=0;r<16;++r){const int orow=crow(r,hi);
      #pragma unroll
      for(int d0=0;d0<2;++d0)stg[orow*64+d0*32+r32]=__float2bfloat16(o[d0][r]*rli[r]);}
    asm volatile("s_waitcnt lgkmcnt(0)":::"memory");
    #pragma unroll
    for(int i=0;i<4;++i){const int row=i*8+(lane>>3),ch=lane&7; const u32x4 v=*(const u32x4*)(stg+row*64+ch*8); ATTN_STORE16(Ow+(long)row*DM+ch*8,v);} }
  asm volatile("s_waitcnt lgkmcnt(0)\n\ts_barrier":::"memory");
  #undef DMA_K
  #undef DMA_V
  #undef CMASK
  #undef START
  #undef RESC
  #undef ROT
}
typedef float f32x4_t __attribute__((ext_vector_type(4)));
#define MFMA16(a,b,c) __builtin_amdgcn_mfma_f32_16x16x32_bf16(a,b,c,0,0,0)
__device__ __forceinline__ bf16x8 vfrag(const s16x4 lo,const s16x4 hi){ return (bf16x8){lo[0],lo[1],lo[2],lo[3],hi[0],hi[1],hi[2],hi[3]}; }
template<int NTP> __device__ __forceinline__ void attn_unit16(int b,int h,int q0,const bf16*Q,const bf16*__restrict__ K,const bf16*__restrict__ V,bf16*O,char*shm,float smax){
  int tid_=threadIdx.x; asm volatile("":"+v"(tid_)); const int tid=tid_,lane=tid&63,l15=lane&15,g=lane>>4; const int wid=__builtin_amdgcn_readfirstlane(tid>>6);
  const long rowbase=(long)b*SKV; const int kvh=h>>2;
  const bf16*Qw=Q+(rowbase+q0+wid*QBLK)*DM+h*D;
  const bf16*Kh=K+rowbase*DM+kvh*D,*Vh=V+rowbase*DM+kvh*D;
  const unsigned lds0=(unsigned)(uintptr_t)shm;
  float*wsf=(float*)(shm+LDS_WS)+wid*64;
  const bf16*ksrc=Kh+(long)lane*DM+wid*8;
  const bf16*vsrc=Vh+(long)(16*(wid&3)+(lane>>2))*DM+(wid>>2)*32+(lane&3)*8;
  const unsigned kdst=lds0+LDS_K+wid*1024, vdst=lds0+LDS_V+wid*1024;
  #define DMA_K(t,slot) glds16(ksrc+(long)(t)*KVBLK*DM,(unsigned)__builtin_amdgcn_readfirstlane(kdst+(slot)))
  #define DMA_V(t,slot) glds16(vsrc+(long)(t)*KVBLK*DM,(unsigned)__builtin_amdgcn_readfirstlane(vdst+(slot)))
  const int rp=8*((l15>>2)&1)+4*(l15>>3)+(l15&3);
  const lds_cptr shm3=(lds_cptr)shm; const lds_cptr kp0=shm3+LDS_K+g*1024+rp*16;
  const lds_cptr vp0=shm3+LDS_V+(8*(g&1)+4*(g>>1)+(l15>>2))*64+(l15&3)*8;
  constexpr int NT=NTP;
  DMA_K(0,0);DMA_V(0,0);DMA_K(1,SLOTB);
  bf16x8 qf[2][2];
  #pragma unroll
  for(int q2=0;q2<2;++q2)
    #pragma unroll
    for(int ds=0;ds<2;++ds)qf[q2][ds]=*reinterpret_cast<const bf16x8*>(&Qw[(long)(16*q2+l15)*DM+32*ds+8*g]);
  f32x4_t o[2][4];
  #pragma unroll
  for(int q2=0;q2<2;++q2)
    #pragma unroll
    for(int db=0;db<4;++db)o[q2][db]=f32x4_t{0.f,0.f,0.f,0.f};
  float ls0=0.f,ls1=0.f;
  f32x4_t negm=f32x4_t{-smax,-smax,-smax,-smax}; asm volatile("":"+v"(negm));
  f32x4_t sA[4][2],sB[4][2]; bf16x8 kf[4][2];
  int sl_prev=0,sl_cur=0,sl_next=SLOTB;
  #define ROT() do{sl_prev=sl_cur;sl_cur=sl_next;sl_next=(sl_next==(NSLOT-1)*SLOTB)?0:sl_next+SLOTB;}while(0)
  #define KLD(kb,ds,slot) kf[kb][ds]=*(const __attribute__((address_space(3))) bf16x8*)(kp0+(slot)+(ds)*4096+(kb)*256)
  #define PIN(x) asm volatile("":"+v"(x))
  #define EX(v) __builtin_amdgcn_exp2f(v)
  DMA_K(2,2*SLOTB);
  WAIT_BAR(3);
  #pragma unroll
  for(int kb=0;kb<4;++kb){KLD(kb,0,0);KLD(kb,1,0);}
  #pragma unroll
  for(int kb=0;kb<4;++kb)
    #pragma unroll
    for(int q2=0;q2<2;++q2){ sA[kb][q2]=MFMA16(kf[kb][0],qf[q2][0],negm); sA[kb][q2]=MFMA16(kf[kb][1],qf[q2][1],sA[kb][q2]); }
  #pragma unroll
  for(int kb=0;kb<4;++kb)
    #pragma unroll
    for(int q2=0;q2<2;++q2)
      #pragma unroll
      for(int r=0;r<4;++r)sA[kb][q2][r]=EX(sA[kb][q2][r]);
  WAIT_BAR(0);
  DMA_K(3,0);DMA_V(1,SLOTB);
  ROT();
  #pragma unroll
  for(int kb=0;kb<4;++kb){KLD(kb,0,sl_cur);KLD(kb,1,sl_cur);}
  WAIT_BAR(2);
  #define VTR(off) vtr(vp_+(off))
  #define STEP16(C,P,t,GK,GV,GL) do{ SBAR(); const lds_cptr vp_=vp0+sl_prev; s16x4 vlo[2][4],vhi[2][4]; u32x4 pw[2][2]; \
    _Pragma("unroll") for(int i_=0;i_<16;++i_){ const int s_=i_>>3,db_=(i_>>1)&3,hf_=i_&1; \
      if(hf_==0) vlo[s_][db_]=VTR(s_*2048+(db_>>1)*4096+(db_&1)*32); else vhi[s_][db_]=VTR(s_*2048+1024+(db_>>1)*4096+(db_&1)*32); SBAR(); \
      { const int ds_=i_>>3,kb_=(i_&7)>>1,q2_=i_&1; C[kb_][q2_]=MFMA16(kf[kb_][ds_],qf[q2_][ds_],ds_==0?negm:C[kb_][q2_]); } \
      { const int pb_=i_>>1,pk_=pb_>>1,pq_=pb_&1; const float a0_=P[pk_][pq_][2*hf_],a1_=P[pk_][pq_][2*hf_+1]; if(pq_==0){ls0+=a0_;ls0+=a1_;PIN(ls0);}else{ls1+=a0_;ls1+=a1_;PIN(ls1);} \
        pw[pq_][pk_>>1][(pk_&1)*2+hf_]=cvtpk_s(a0_,a1_); PIN(pw[pq_][pk_>>1]); } SBAR(); } \
    if(GK){DMA_K((t)+3,sl_cur);} if(GV){DMA_V((t)+1,sl_next);} SBAR(); \
    _Pragma("unroll") for(int i_=0;i_<16;++i_){ const int s_=i_>>3,q2_=(i_&7)>>2,db_=i_&3; \
      if((GL)&&i_>=4&&i_<12){ const int j_=i_-4; KLD(j_>>1,j_&1,sl_next); SBAR(); } \
      o[q2_][db_]=MFMA16(__builtin_bit_cast(bf16x8,pw[q2_][s_]),vfrag(vlo[s_][db_],vhi[s_][db_]),o[q2_][db_]); \
      { const int cb_=i_>>1,ck_=cb_>>1,cq_=cb_&1,hf_=i_&1; C[ck_][cq_][2*hf_]=EX(C[ck_][cq_][2*hf_]); C[ck_][cq_][2*hf_+1]=EX(C[ck_][cq_][2*hf_+1]); PIN(C[ck_][cq_]); } SBAR(); } \
    }while(0)
  int t=1;
  for(;t+5<NT;t+=2){
    STEP16(sB,sA,t,true,true,true);     WAIT_BAR(2); ROT();
    STEP16(sA,sB,t+1,true,true,true);   WAIT_BAR(2); ROT();
  }
  #define ENDW(tt) do{ if((tt)+3<NT){WAIT_BAR(2);} else if((tt)+2<NT){WAIT_BAR(1);} else {WAIT_BAR(0);} }while(0)
  for(;t+1<NT;t+=2){
    STEP16(sB,sA,t,(t+3<NT),(t+1<NT),(t+1<NT));       ENDW(t);   ROT();
    STEP16(sA,sB,t+1,(t+4<NT),(t+2<NT),(t+2<NT));     ENDW(t+1); ROT();
  }
  STEP16(sB,sA,NT-1,false,false,false);
  { const lds_cptr vp_=vp0+sl_cur; u32x4 pw[2][2];
    #pragma unroll
    for(int kb=0;kb<4;++kb)
      #pragma unroll
      for(int q2=0;q2<2;++q2){ const f32x4_t p=sB[kb][q2]; if(q2==0)ls0+=(p[0]+p[1])+(p[2]+p[3]); else ls1+=(p[0]+p[1])+(p[2]+p[3]); pw[q2][kb>>1][(kb&1)*2]=cvtpk_s(p[0],p[1]); pw[q2][kb>>1][(kb&1)*2+1]=cvtpk_s(p[2],p[3]); }
    #pragma unroll
    for(int s=0;s<2;++s)
      #pragma unroll
      for(int db=0;db<4;++db){ const s16x4 lo=VTR(s*2048+(db>>1)*4096+(db&1)*32), hi=VTR(s*2048+1024+(db>>1)*4096+(db&1)*32); const bf16x8 vf=vfrag(lo,hi);
        #pragma unroll
        for(int q2=0;q2<2;++q2)o[q2][db]=MFMA16(__builtin_bit_cast(bf16x8,pw[q2][s]),vf,o[q2][db]); } }
  ls0+=__shfl_xor(ls0,16); ls0+=__shfl_xor(ls0,32); ls1+=__shfl_xor(ls1,16); ls1+=__shfl_xor(ls1,32);
  if(g==0){wsf[l15]=ls0;wsf[16+l15]=ls1;} asm volatile("s_waitcnt lgkmcnt(0)":::"memory");
  bf16*Ow=O+(rowbase+q0+wid*QBLK)*DM+h*D;
  { bf16*stg=(bf16*)(shm+LDS_OST)+wid*2048;
    #pragma unroll
    for(int q2=0;q2<2;++q2)
      #pragma unroll
      for(int r=0;r<4;++r){ const int orow=16*q2+4*g+r; const float rl=__builtin_amdgcn_rcpf(wsf[orow]);
        #pragma unroll
        for(int db=0;db<4;++db)stg[orow*64+16*db+l15]=__float2bfloat16(o[q2][db][r]*rl); }
    asm volatile("s_waitcnt lgkmcnt(0)":::"memory");
    #pragma unroll
    for(int i=0;i<4;++i){const int row=i*8+(lane>>3),ch=lane&7; const u32x4 v=*(const u32x4*)(stg+row*64+ch*8); ATTN_STORE16(Ow+(long)row*DM+ch*8,v);} }
  asm volatile("s_waitcnt lgkmcnt(0)\n\ts_barrier":::"memory");
  #undef DMA_K
  #undef DMA_V
  #undef ROT
  #undef KLD
  #undef PIN
  #undef EX
  #undef VTR
  #undef STEP16
  #undef ENDW
}
constexpr int ATTN_LDS_BYTES=LDS_BYTES;
constexpr int N_UNITS=8*8*NQB;
template<int THRL,bool FIXREF> __device__ __forceinline__ void attn_phase(char*lds,bf16*Z,bf16*Ob,int G,int vcu,float smax,const float*qg,const float*ropeT){
  for(int L=vcu;L<N_UNITS;L+=G){ const int pair=L>>7,rem=L&127,b=pair>>1,h=(pair&1)*4+(rem>>5),qb=rem&31;
    if constexpr(FIXREF) attn_unit16<SKV/KVBLK>(b,h,SCTX+qb*QB,Z,Z+1024,Z+1152,Ob,lds,smax); else attn_unit<THRL,false,SKV/KVBLK>(b,h,SCTX+qb*QB,Z,Z+1024,Z+1152,Ob,lds,smax,qg,ropeT); }
  for(int L=vcu;L<64;L+=G){ const int b=L>>3,h=L&7;
    if constexpr(FIXREF) attn_unit16<SCTX/KVBLK>(b,h,0,Z,Z+1024,Z+1152,Ob,lds,smax); else attn_unit<THRL,false,SCTX/KVBLK>(b,h,0,Z,Z+1024,Z+1152,Ob,lds,smax,qg,ropeT); }
}
#undef SBAR
#undef WAIT_BAR
}
constexpr int NWAVES = 8;
#ifndef MK_PER_PHASE
#define MK_PER_PHASE 0
#endif
constexpr int NPHASE = 16;
#ifndef PROBE_DUP
#define PROBE_DUP -1
#endif
#ifndef PROBE_NOSTORE
#define PROBE_NOSTORE 0
#endif

constexpr int NB = 8, SEQ = 8192, DMODEL = 1024, CTXL = 256, SROW = SEQ + CTXL  ;
constexpr int MC = NB * SROW  , ML = NB * SEQ  ;
constexpr int ZP = 2304;
constexpr int DFF = 2816, DFE = 1408, NEXP = 8, NMODV = 6 * DMODEL;
constexpr int MS_MAX = 2 * ML + NEXP * 256;
constexpr float EPS = 1e-6f;
constexpr float QSCALE = 0.125f * 1.4426950408889634f;

constexpr size_t MiB = 1u << 20;
constexpr size_t WS_CTL = 0, CTL_ZERO_BYTES = 1 * MiB;
constexpr size_t WS_MOD = 1 * MiB;
constexpr size_t WS_ROPE = WS_MOD + 512 * 1024;
constexpr size_t WS_HIST = WS_ROPE + 64 * 1024;
constexpr size_t WS_TOKRS = WS_HIST + 128 * 1024;
constexpr size_t WS_GSC = WS_HIST + 64 * 1024;
constexpr size_t WS_TOKE = 2 * MiB, WS_TOKR = WS_TOKE + 256 * 1024, WS_TOKP = WS_TOKR + 256 * 1024, WS_TOKS = WS_TOKP + 256 * 1024;
constexpr size_t WS_TOKL = 3 * MiB + 256 * 1024;
constexpr size_t WS_SSQ = 4 * MiB;
constexpr size_t WS_WIN = 8 * MiB, WS_WOUT = 13 * MiB, WS_WGU = 15 * MiB, WS_WD = 26 * MiB, WS_WP = 32 * MiB, WS_WEGU = 33 * MiB, WS_WED = 77 * MiB;
constexpr size_t WS_A = 104 * MiB;
constexpr size_t WS_R1 = 240 * MiB;
constexpr size_t WS_R2 = 600 * MiB;
constexpr size_t WS_XR = 864 * MiB;
constexpr size_t WS_XRC = 99 * MiB;
constexpr size_t WS_A1C = 236 * MiB;
constexpr size_t WS_HC = 992 * MiB;
constexpr size_t WS_YC = 1003 * MiB;
constexpr size_t WS_END = 1011 * MiB;
static_assert(WS_WED + (size_t)NEXP * 1024 * DFE * 2 <= WS_A && WS_A + (size_t)MC * 1024 * 2 <= WS_R1 && WS_R1 + (size_t)MS_MAX * DFE * 2 <= WS_R2 && WS_R1 + (size_t)ML * DFF * 2 <= WS_R2 && WS_R2 + (size_t)MS_MAX * 1024 * 2 <= WS_XR && WS_XR + (size_t)ML * 1024 * 2 <= WS_END, "d_ws map");
constexpr int CW_TMO = 0, CW_CODE = 1;
constexpr int CW_BAR = 4096;

constexpr int RING_OFF = 0, RING_BYTES = 131072;
constexpr int LDSCTL_OFF = RING_BYTES, MISC_OFF = LDSCTL_OFF + 320;
constexpr int LDS_BYTES = 147456;
static_assert(MISC_OFF + 128 <= LDS_BYTES, "LDS map");
#define GAS __attribute__((address_space(1)))
#define LAS __attribute__((address_space(3)))
typedef unsigned short bf16;
typedef unsigned v4u __attribute__((ext_vector_type(4)));
typedef float f32x4 __attribute__((ext_vector_type(4)));
typedef short bf16x8 __attribute__((ext_vector_type(8)));
typedef GAS unsigned gu32;
typedef GAS unsigned long long gu64;
#define RLX_AGENT __ATOMIC_RELAXED, __HIP_MEMORY_SCOPE_AGENT
#define LDS_WAIT() asm volatile("s_waitcnt lgkmcnt(0)" ::: "memory")
#define VM_WAIT() asm volatile("s_waitcnt vmcnt(0)" ::: "memory")
__device__ __forceinline__ unsigned long long rt() { return __builtin_amdgcn_s_memrealtime(); }
__device__ __forceinline__ unsigned f2bf(float f) { unsigned u = __builtin_bit_cast(unsigned, f); return (u + 0x7fffu + ((u >> 16) & 1u)) >> 16; }
__device__ __forceinline__ unsigned pk2(float lo, float hi) { return f2bf(lo) | (f2bf(hi) << 16); }

#define XB_TMO      128
#define XB_XCNT(j)  (256  + 64 * (j))
#define XB_XSUB(j)  (1280 + 64 * (j))
#define XB_XGEN(j)  (2304 + 64 * (j))
#define XB_TOP      3328
#define XB_TOPGEN   3392
#define XCD_BAR_WORDS 3456
#define XB_SPIN_CAP (1u << 18)

__device__ __forceinline__ unsigned xb_ld(unsigned* p)              { return __hip_atomic_load(p, __ATOMIC_RELAXED, __HIP_MEMORY_SCOPE_AGENT); }
__device__ __forceinline__ unsigned xb_add(unsigned* p, unsigned v) { return __hip_atomic_fetch_add(p, v, __ATOMIC_RELAXED, __HIP_MEMORY_SCOPE_AGENT); }
__device__ __forceinline__ unsigned xb_xcc_id() { return (unsigned)__builtin_amdgcn_s_getreg((3 << 11) | 20) & 0xFu; }
#define XB_SPIN(cond, bar) do { unsigned _sp = 0; while (cond) { __builtin_amdgcn_s_sleep(1); \
    if ((++_sp & 255u) == 0u) { if (xb_ld(&(bar)[XB_TMO])) break; if (_sp > XB_SPIN_CAP) { atomicAdd(&(bar)[XB_TMO], 1u); break; } } } } while (0)

struct XcdBarrier {
    unsigned* bar; unsigned x;
    volatile LAS unsigned* st;
};

__device__ __forceinline__ XcdBarrier xcd_barrier_post(unsigned* bar, volatile LAS unsigned* st) {
    XcdBarrier b; b.bar = bar; b.x = xb_xcc_id(); b.st = st;
    if (threadIdx.x == 0) (void)xb_add(&bar[XB_XCNT(b.x)], 1u);
    return b;
}
__device__ __forceinline__ void xcd_barrier_complete(unsigned* bar, unsigned x, unsigned& nloc, unsigned& nx) {
    const unsigned G = gridDim.x * gridDim.y * gridDim.z;
    unsigned sum, cnt, mine, sp = 0u;
    for (;;) {
        sum = 0u; cnt = 0u; mine = 0u;
#pragma unroll
        for (unsigned j = 0; j < 16; ++j) { const unsigned c = xb_ld(&bar[XB_XCNT(j)]); sum += c; cnt += (c > 0u) ? 1u : 0u; mine = (j == x) ? c : mine; }
        if (sum == G) break;
        __builtin_amdgcn_s_sleep(1);
        if ((++sp & 255u) == 0u) { if (xb_ld(&bar[XB_TMO])) break; if (sp > XB_SPIN_CAP) { atomicAdd(&bar[XB_TMO], 1u); break; } }
    }
    nloc = mine > 0u ? mine : 1u; nx = cnt > 0u ? cnt : 1u;
}

__device__ __forceinline__ void xcd_barrier(const XcdBarrier& b) {
    asm volatile("s_waitcnt vmcnt(0)" ::: "memory");
    __syncthreads();
    if (threadIdx.x == 0) {
        unsigned* bar = b.bar;
        __builtin_amdgcn_s_waitcnt(0);
        unsigned nloc = b.st[0], nx = b.st[1];
        if (nloc == 0u) { xcd_barrier_complete(bar, b.x, nloc, nx); b.st[0] = nloc; b.st[1] = nx; }
        const unsigned old = xb_add(&bar[XB_XSUB(b.x)], 1u);
        const unsigned gen = old / nloc;
        if (old + 1u == (gen + 1u) * nloc) {
            __builtin_amdgcn_fence(__ATOMIC_RELEASE, "agent");
            asm volatile("s_waitcnt vmcnt(0)" ::: "memory");
            const unsigned og = xb_add(&bar[XB_TOP], 1u);
            const unsigned tg = og / nx;
            if (og + 1u == (tg + 1u) * nx) xb_add(&bar[XB_TOPGEN], 1u);
            else XB_SPIN(xb_ld(&bar[XB_TOPGEN]) == tg, bar);
            __builtin_amdgcn_fence(__ATOMIC_ACQUIRE, "agent");
            xb_add(&bar[XB_XGEN(b.x)], 1u);
            asm volatile("s_waitcnt vmcnt(0)" ::: "memory");
        } else {
            XB_SPIN(xb_ld(&bar[XB_XGEN(b.x)]) == gen, bar);
            __builtin_amdgcn_fence(__ATOMIC_ACQUIRE, "agent");
            asm volatile("s_waitcnt vmcnt(0)" ::: "memory");
        }
    }
    __syncthreads();
}
struct Args { const float* in[23]; float* out; unsigned char* ws; int ph_lo, ph_hi; };
struct Frame {
    LAS unsigned char* lds;
    volatile LAS unsigned* MISC;
    gu32* ctl;
    unsigned char* ws;
    int tid, lane, wave;
    int vcu, G;
};
__device__ __forceinline__ float wave_sum(float v) {
#pragma unroll
    for (int o = 1; o < 64; o <<= 1) v += __shfl_xor(v, o);
    return v;
}
__device__ __forceinline__ float bf_lo(unsigned w) { return __uint_as_float(w << 16); }
__device__ __forceinline__ float bf_hi(unsigned w) { return __uint_as_float(w & 0xffff0000u); }
__device__ __forceinline__ unsigned pkbf(float lo, float hi) { return pg8::cvt_pk_bf16(lo, hi); }
__device__ __forceinline__ f32x4 ld_xr4(const bf16* p) { const unsigned long long w = *(const GAS unsigned long long*)p; const unsigned a = (unsigned)w, b = (unsigned)(w >> 32); return (f32x4){bf_lo(a), bf_hi(a), bf_lo(b), bf_hi(b)}; }

struct GridOrder {
    int nM, nN, G, c; bool mapA;
    __device__ __forceinline__ bool next(int i, pg8::Unit& u) const {
        const long L = (long)i * G + c; if (L >= (long)nM * nN) return false;
        int pm, pn; pg8::tile_map((int)L, nM, nN, pm, pn); u.om = pm; u.pm = mapA ? pm + (pm >> 5) + 1 : pm; u.pn = pn; u.e = 0; return true; }
    __device__ __forceinline__ void a_ready(const pg8::Unit&) const {}
    __device__ __forceinline__ void done(const pg8::Unit&) const {}
};
struct InProjOrder {
    int G, c;
    __device__ __forceinline__ bool next(int i, pg8::Unit& u) const {
        const long L = (long)i * G + c; if (L >= 2304 + 9 * NB) return false;
        if (L < 2304) { int pm, pn; pg8::tile_map((int)L, 256, 9, pm, pn); u.pm = pm + (pm >> 5) + 1; u.pn = pn; }
        else { const int j = (int)L - 2304; u.pm = (j / 9) * 33; u.pn = j % 9; }
        u.om = u.pm; u.e = 0; return true; }
    __device__ __forceinline__ void a_ready(const pg8::Unit&) const {}
    __device__ __forceinline__ void done(const pg8::Unit&) const {}
};
struct CtxOrder {
    int nN, G, j; bool mapA;
    __device__ __forceinline__ bool next(int i, pg8::Unit& u) const {
        const long L = (long)i * G + j; if (L >= (long)NB * nN) return false;
        const int b = (int)L / nN; u.pn = (int)L - b * nN; u.om = b; u.pm = mapA ? b * 33 : b; u.e = 0; return true; }
    __device__ __forceinline__ void a_ready(const pg8::Unit&) const {}
    __device__ __forceinline__ void done(const pg8::Unit&) const {}
};
struct CtxSplitKOrder {
    int G, j;
    __device__ __forceinline__ bool next(int i, pg8::Unit& u) const {
        const long L = (long)i * G + j; if (L >= 64) return false;
        const int b = (int)L >> 3, r = (int)L & 7; u.pn = r & 3; u.e = r >> 2; u.pm = 2 * b + u.e; u.om = u.pm; return true; }
    __device__ __forceinline__ void a_ready(const pg8::Unit&) const {}
    __device__ __forceinline__ void done(const pg8::Unit&) const {}
};
struct MoeOrder {
    int nM, nN, G, c; int ts1, ts2, ts3, ts4, ts5, ts6, ts7;
    __device__ __forceinline__ bool next(int i, pg8::Unit& u) const {
        const long L = (long)i * G + c; if (L >= (long)nM * nN) return false;
        int pm, pn; pg8::tile_map((int)L, nM, nN, pm, pn); u.pm = pm; u.om = pm; u.pn = pn;
        u.e = (pm >= ts1) + (pm >= ts2) + (pm >= ts3) + (pm >= ts4) + (pm >= ts5) + (pm >= ts6) + (pm >= ts7); return true; }
    __device__ __forceinline__ void a_ready(const pg8::Unit&) const {}
    __device__ __forceinline__ void done(const pg8::Unit&) const {}
};

__device__ __forceinline__ void p0_transpose_item(const float* W, int N, bf16* WT, int Kd, int k0, int n0, int drow0, LAS float* scr, int lane, bool fine = false) {
#pragma unroll 8
    for (int i = 0; i < 32; ++i) { const int kk = 2 * i + (lane >> 5); scr[kk * 33 + (lane & 31)] = W[(size_t)(k0 + kk) * N + n0 + (lane & 31)]; }
    LDS_WAIT(); asm volatile("" ::: "memory");
    const int c = lane & 7;
#pragma unroll
    for (int j = 0; j < 4; ++j) { const int n = (lane >> 3) + 8 * j; const LAS float* s = scr + (8 * c) * 33 + n;
        v4u o; o.x = pkbf(s[0 * 33], s[1 * 33]); o.y = pkbf(s[2 * 33], s[3 * 33]); o.z = pkbf(s[4 * 33], s[5 * 33]); o.w = pkbf(s[6 * 33], s[7 * 33]);
        const int nd = fine ? 8 * ((n & 15) >> 2) + 4 * (n >> 4) + (n & 3) : n;
        *(GAS v4u*)(WT + (size_t)(drow0 + nd) * Kd + k0 + 8 * c) = o; }
    LDS_WAIT(); asm volatile("" ::: "memory");
}
__device__ __forceinline__ bool p0_mats(int& it, const float* W, int K, int N, bf16* WT, int maptype, int half, int nmat, int dstN, LAS float* scr, int lane) {
    const int nblk = N / 32, per = (K / 64) * nblk, nitems = per * nmat;
    if (it >= nitems) { it -= nitems; return false; }
    const int e = it / per, r = it - e * per, kb = r / nblk, nb = r - kb * nblk, k0 = 64 * kb, n0 = 32 * nb;
    int d;
    if (maptype == 0) d = n0;
    else if (maptype == 1) { d = n0 < 512 ? n0 : n0 < 768 ? n0 + 512 : n0 < 1280 ? n0 - 256 : n0 < 1792 ? 1280 + ((n0 - 1280) >> 7) * 256 + ((n0 - 1280) & 127) : 1280 + ((n0 - 1792) >> 7) * 256 + 128 + ((n0 - 1792) & 127);
        if (d < 1280) d = (d & ~255) + ((d >> 5) & 1) * 128 + ((d >> 6) & 3) * 32; }
    else d = (n0 >> 7) * 256 + (n0 & 127) + half * 128;
    p0_transpose_item(W + (size_t)e * K * N, N, WT + (size_t)e * dstN * K, K, k0, n0, d, scr, lane, maptype == 1 && (n0 < 640));
    return true;
}
__device__ __forceinline__ void p0_prologue(const Args& a, const Frame& F) {
    float* mod = (float*)(F.ws + WS_MOD);
    { LAS float* sl = (LAS float*)(F.lds + RING_OFF); LAS float* red = sl + 9 * 1024;
      for (int idx = F.tid; idx < 9 * 1024; idx += NWAVES * 64) { const int r = idx >> 10, k = idx & 1023; const float v = r < 8 ? a.in[1][r * 1024 + k] : a.in[3][k]; sl[idx] = v / (1.0f + __expf(-v)); }
      __syncthreads();
      for (int task = blockIdx.x; task < 192; task += F.G) { const int i = task / 96, n0 = (task % 96) * 64;
          float acc[9];
#pragma unroll
          for (int r = 0; r < 9; ++r) acc[r] = 0.f;
          const float* wp = a.in[4] + ((size_t)i * 1024 + F.wave * 128) * NMODV + n0 + F.lane;
#pragma unroll 4
          for (int k = 0; k < 128; ++k) { const float wv = wp[(size_t)k * NMODV];
#pragma unroll
              for (int r = 0; r < 9; ++r) acc[r] += sl[r * 1024 + F.wave * 128 + k] * wv; }
#pragma unroll
          for (int r = 0; r < 9; ++r) red[(F.wave * 9 + r) * 64 + F.lane] = acc[r];
          __syncthreads();
          for (int idx = F.tid; idx < 9 * 64; idx += NWAVES * 64) { const int r = idx >> 6, l = idx & 63; float s = 0.f;
#pragma unroll
              for (int w = 0; w < 8; ++w) s += red[(w * 9 + r) * 64 + l];
              mod[(size_t)(i * 9 + r) * NMODV + n0 + l] = s + a.in[5][i * NMODV + n0 + l]; }
          __syncthreads(); }
    }
    { float* rt_ = (float*)(F.ws + WS_ROPE); const int gt = blockIdx.x * (NWAVES * 64) + F.tid;
      if (gt < 192 * 16) { const int p = gt >> 4, i = gt & 15; const float pos = (float)(p < 128 ? p : p - 128); const float freq = exp2f(-(float)i * (13.287712379549449f / 16.0f)); const float ang = pos * freq;
          rt_[gt * 2] = cosf(ang); rt_[gt * 2 + 1] = sinf(ang); } }
    __syncthreads();
    LAS float* scr = (LAS float*)(F.lds + RING_OFF + F.wave * 16384);
    const int gw = F.vcu * NWAVES + F.wave, NGW = F.G * NWAVES;
    constexpr int NITEMS = 1152 + 512 + 3 * 1408 + 128 + 3 * 5632;
    for (int it0 = gw; it0 < NITEMS; it0 += NGW) { int it = it0;
        if (p0_mats(it, a.in[8], 1024, 2304, (bf16*)(F.ws + WS_WIN), 1, 0, 1, 2304, scr, F.lane)) continue;
        if (p0_mats(it, a.in[12], 1024, 1024, (bf16*)(F.ws + WS_WOUT), 0, 0, 1, 1024, scr, F.lane)) continue;
        if (p0_mats(it, a.in[13], 1024, DFF, (bf16*)(F.ws + WS_WGU), 2, 0, 1, 2 * DFF, scr, F.lane)) continue;
        if (p0_mats(it, a.in[14], 1024, DFF, (bf16*)(F.ws + WS_WGU), 2, 1, 1, 2 * DFF, scr, F.lane)) continue;
        if (p0_mats(it, a.in[15], DFF, 1024, (bf16*)(F.ws + WS_WD), 0, 0, 1, 1024, scr, F.lane)) continue;
        if (p0_mats(it, a.in[16], 256, 256, (bf16*)(F.ws + WS_WP), 0, 0, 4, 256, scr, F.lane)) continue;
        if (p0_mats(it, a.in[20], 1024, DFE, (bf16*)(F.ws + WS_WEGU), 2, 0, NEXP, 2 * DFE, scr, F.lane)) continue;
        if (p0_mats(it, a.in[21], 1024, DFE, (bf16*)(F.ws + WS_WEGU), 2, 1, NEXP, 2 * DFE, scr, F.lane)) continue;
        p0_mats(it, a.in[22], DFE, 1024, (bf16*)(F.ws + WS_WED), 0, 0, NEXP, 1024, scr, F.lane);
    }
}

template <int MODE> __device__ __forceinline__ void norm_mod_phase(const Args& a, const Frame& F, int wgi, int nwg) {
    const int gw = wgi * NWAVES + F.wave, NGW = nwg * NWAVES;
    constexpr int nrows = MODE == 0 ? MC : ML; const int rpw = (nrows + NGW - 1) / NGW;
    const float* mod = (const float*)(F.ws + WS_MOD); const float* ng = a.in[6] + (MODE == 0 ? 0 : 1024);
    constexpr int SH = MODE == 0 ? 0 : 3, SC = SH + 1;
    bf16* A = (bf16*)(F.ws + WS_A);
    int cur_r = -1; f32x4 gm[4], sh[4];
    int R1 = (gw + 1) * rpw; if (R1 > nrows) R1 = nrows;
    constexpr int NR = 4;
    struct Batch { f32x4 v[NR][4]; unsigned long long raw[NR][4]; int rr[NR]; };
    auto load = [&](Batch& B, const int Rg) {
#pragma unroll
        for (int q = 0; q < NR; ++q) { const int R = Rg + q < R1 ? Rg + q : R1 - 1; const float* src;
            if (MODE == 0) { const int b = R / SROW, s = R - b * SROW; if (s < CTXL) { src = a.in[2] + ((size_t)b * CTXL + s) * 1024; B.rr[q] = 8; } else { src = a.in[0] + ((size_t)b * SEQ + (s - CTXL)) * 1024; B.rr[q] = b; } }
            else { src = nullptr; B.rr[q] = R / SEQ; }
#pragma unroll
            for (int j = 0; j < 4; ++j) { if (MODE == 0) B.v[q][j] = *(const GAS f32x4*)(src + 4 * F.lane + 256 * j); else B.raw[q][j] = *(const GAS unsigned long long*)((const bf16*)(F.ws + WS_XR) + (size_t)R * 1024 + 4 * F.lane + 256 * j); } }
    };
    auto process = [&](Batch& B, const int Rg) {
#pragma unroll
        for (int q = 0; q < NR; ++q) { const int R = Rg + q; if (R < R1) {
            if (B.rr[q] != cur_r) { cur_r = B.rr[q];
#pragma unroll
                for (int j = 0; j < 4; ++j) { const int col = 4 * F.lane + 256 * j; const f32x4 g = *(const f32x4*)(ng + col), sc = *(const f32x4*)(mod + (size_t)cur_r * NMODV + SC * 1024 + col);
                    gm[j] = g * (sc + 1.0f); sh[j] = *(const f32x4*)(mod + (size_t)cur_r * NMODV + SH * 1024 + col); } }
            f32x4 v[4];
#pragma unroll
            for (int j = 0; j < 4; ++j) { if (MODE == 0) v[j] = B.v[q][j]; else { const unsigned lo = (unsigned)B.raw[q][j], hi = (unsigned)(B.raw[q][j] >> 32); v[j] = (f32x4){bf_lo(lo), bf_hi(lo), bf_lo(hi), bf_hi(hi)}; } }
            float ss = 0.f;
#pragma unroll
            for (int j = 0; j < 4; ++j) ss += (v[j].x * v[j].x + v[j].y * v[j].y) + (v[j].z * v[j].z + v[j].w * v[j].w);
            const float rstd = rsqrtf(wave_sum(ss) * (1.0f / 1024.0f) + EPS);
#pragma unroll
            for (int j = 0; j < 4; ++j) { const f32x4 o = v[j] * rstd * gm[j] + sh[j];
                const int c_ = 4 * F.lane + 256 * j; const size_t di = MODE == 1 ? ((size_t)((R >> 8) * 16 + (c_ >> 6)) * 16384 + (size_t)(R & 255) * 64 + (c_ & 63)) : ((size_t)R * 1024 + c_);
                *(GAS unsigned long long*)(A + di) = (unsigned long long)pkbf(o.x, o.y) | ((unsigned long long)pkbf(o.z, o.w) << 32); } } }
    };
    Batch BA, BB;
    int Rg = gw * rpw;
    if (Rg < R1) load(BA, Rg);
#pragma unroll 1
    for (; Rg < R1; Rg += 2 * NR) {
        const bool more = Rg + NR < R1;
        if (more) load(BB, Rg + NR);
        process(BA, Rg);
        if (more) { if (Rg + 2 * NR < R1) load(BA, Rg + 2 * NR); process(BB, Rg + NR); }
    }
}

__device__ __forceinline__ void unpack8(const v4u w, float (&v)[8]) { v[0] = bf_lo(w.x); v[1] = bf_hi(w.x); v[2] = bf_lo(w.y); v[3] = bf_hi(w.y); v[4] = bf_lo(w.z); v[5] = bf_hi(w.z); v[6] = bf_lo(w.w); v[7] = bf_hi(w.w); }
__device__ __forceinline__ v4u pack8(const float (&v)[8]) { v4u w; w.x = pkbf(v[0], v[1]); w.y = pkbf(v[2], v[3]); w.z = pkbf(v[4], v[5]); w.w = pkbf(v[6], v[7]); return w; }
__device__ __forceinline__ v4u qk_head(const v4u w, const float* g8, const float* ropeT, bool do_rope, int prow, int pcol, float scale, int lane) {
    float v[8]; unpack8(w, v); float ss = 0.f;
#pragma unroll
    for (int e = 0; e < 8; ++e) ss += v[e] * v[e];
    ss += __shfl_xor(ss, 1); ss += __shfl_xor(ss, 2); ss += __shfl_xor(ss, 4);
    const float rstd = rsqrtf(ss * (1.0f / 64.0f) + EPS);
    const f32x4 g0 = *(const f32x4*)g8, g1 = *(const f32x4*)(g8 + 4);
    v[0] *= rstd * g0.x; v[1] *= rstd * g0.y; v[2] *= rstd * g0.z; v[3] *= rstd * g0.w; v[4] *= rstd * g1.x; v[5] *= rstd * g1.y; v[6] *= rstd * g1.z; v[7] *= rstd * g1.w;
    if (do_rope) {
        const int axis = (lane >> 2) & 1, pos = axis ? 128 + pcol : prow; const float* tp = ropeT + ((size_t)pos * 16 + (lane & 1) * 8) * 2; const bool second = (lane & 2) != 0;
#pragma unroll
        for (int e = 0; e < 8; ++e) { const float other = __shfl_xor(v[e], 2); const float c = tp[2 * e], s = tp[2 * e + 1];
            v[e] = second ? (other * s + v[e] * c) : (v[e] * c - other * s); }
    }
#pragma unroll
    for (int e = 0; e < 8; ++e) v[e] *= scale;
    return pack8(v);
}
__device__ __forceinline__ void gcu_prod(const bf16* zr, int lane, float (&o)[8]) {
    const v4u pr = *(const GAS v4u*)(zr + 1280 + lane * 8); unpack8(pr, o);
}
__device__ __forceinline__ void p3_postproc(const Args& a, const Frame& F) {
    const int gw = F.vcu * NWAVES + F.wave, NGW = F.G * NWAVES, lane = F.lane;
    bf16* Z = (bf16*)(F.ws + WS_R1);
    float w0[8], w1[8], w2[8];
    { const f32x4 c00 = *(const f32x4*)(a.in[11] + lane * 8), c01 = *(const f32x4*)(a.in[11] + lane * 8 + 4), c10 = *(const f32x4*)(a.in[11] + 512 + lane * 8), c11 = *(const f32x4*)(a.in[11] + 512 + lane * 8 + 4),
                  c20 = *(const f32x4*)(a.in[11] + 1024 + lane * 8), c21 = *(const f32x4*)(a.in[11] + 1024 + lane * 8 + 4);
      w0[0] = c00.x; w0[1] = c00.y; w0[2] = c00.z; w0[3] = c00.w; w0[4] = c01.x; w0[5] = c01.y; w0[6] = c01.z; w0[7] = c01.w;
      w1[0] = c10.x; w1[1] = c10.y; w1[2] = c10.z; w1[3] = c10.w; w1[4] = c11.x; w1[5] = c11.y; w1[6] = c11.z; w1[7] = c11.w;
      w2[0] = c20.x; w2[1] = c20.y; w2[2] = c20.z; w2[3] = c20.w; w2[4] = c21.x; w2[5] = c21.y; w2[6] = c21.z; w2[7] = c21.w; }
    for (int i = gw; i < NB * CTXL; i += NGW) { const int b = i / CTXL, s = i - b * CTXL; bf16* zr = Z + (size_t)(b * SROW + s) * ZP;
        float pv[8], cu[8], nx[8];
        if (s > 0) gcu_prod(zr - ZP, lane, pv); else {
#pragma unroll
            for (int e = 0; e < 8; ++e) pv[e] = 0.f; }
        gcu_prod(zr, lane, cu);
        if (s + 1 < CTXL) gcu_prod(zr + ZP, lane, nx); else {
#pragma unroll
            for (int e = 0; e < 8; ++e) nx[e] = 0.f; }
        { float gb[8], o[8]; unpack8(*(const GAS v4u*)(zr + 512 + lane * 8), gb);
#pragma unroll
          for (int e = 0; e < 8; ++e) o[e] = gb[e] * (w0[e] * pv[e] + w1[e] * cu[e] + w2[e] * nx[e]);
          *(GAS v4u*)(zr + 512 + lane * 8) = pack8(o); }
    }
    for (int ch = gw; ch < ML / 32; ch += NGW) {
        const int n0 = ch * 32, b = n0 / SEQ, t0 = n0 - b * SEQ; bf16* z0 = Z + (size_t)(b * SROW + CTXL + t0) * ZP;
        float prev[8], cur[8];
        if (t0 > 0) gcu_prod(z0 - ZP, lane, prev); else {
#pragma unroll
            for (int e = 0; e < 8; ++e) prev[e] = 0.f; }
        gcu_prod(z0, lane, cur);
        for (int i0 = 0; i0 < 32; i0 += 4) {
            v4u gcw[4], gbw[4];
#pragma unroll
            for (int q = 0; q < 4; ++q) { const int t = t0 + i0 + q; const bf16* zr = z0 + (size_t)(i0 + q) * ZP; const bf16* zn = (t + 1 < SEQ) ? zr + ZP : zr;
                gcw[q] = *(const GAS v4u*)(zn + 1280 + lane * 8); gbw[q] = *(const GAS v4u*)(zr + 512 + lane * 8); }
#pragma unroll
            for (int q = 0; q < 4; ++q) { const int t = t0 + i0 + q; bf16* zr = z0 + (size_t)(i0 + q) * ZP;
                float nxt[8]; { float x[8]; unpack8(gcw[q], x); const bool has = t + 1 < SEQ;
#pragma unroll
                    for (int e = 0; e < 8; ++e) nxt[e] = has ? x[e] : 0.f; }
                { float gb[8], o[8]; unpack8(gbw[q], gb);
#pragma unroll
                  for (int e = 0; e < 8; ++e) { o[e] = gb[e] * (w0[e] * prev[e] + w1[e] * cur[e] + w2[e] * nxt[e]); prev[e] = cur[e]; cur[e] = nxt[e]; }
                  *(GAS v4u*)(zr + 512 + lane * 8) = pack8(o); } }
        }
    }
}
template <int HW> __device__ __forceinline__ void p9_task(const bf16* xb, const float* ssq_b, bf16* Pb, int t0, const f32x4 gm, const f32x4 sh, int col, int lane) {
    const int rstart = t0 - HW;
    float rs0, rs1;
    { const int r0 = rstart + lane, r1 = rstart + 64 + lane; float s0 = 0.f, s1 = 0.f;
      if (r0 >= 0 && r0 < SEQ) {
#pragma unroll
          for (int k = 0; k < 4; ++k) { const f32x4 v = *(const f32x4*)(ssq_b + (size_t)r0 * 16 + 4 * k); s0 += (v.x + v.y) + (v.z + v.w); } }
      if (lane < 16 && r1 >= 0 && r1 < SEQ) {
#pragma unroll
          for (int k = 0; k < 4; ++k) { const f32x4 v = *(const f32x4*)(ssq_b + (size_t)r1 * 16 + 4 * k); s1 += (v.x + v.y) + (v.z + v.w); } }
      rs0 = rsqrtf(s0 * (1.0f / 1024.0f) + EPS); rs1 = rsqrtf(s1 * (1.0f / 1024.0f) + EPS); }
    f32x4 ring[2 * HW];
#pragma unroll
    for (int k = 0; k < 2 * HW; ++k) ring[k] = (f32x4){0.f, 0.f, 0.f, 0.f};
    f32x4 sum = (f32x4){0.f, 0.f, 0.f, 0.f};
    unsigned long long rawA[16], rawB[16];
#define P9_LOAD(raw, base_) do { _Pragma("unroll") for (int k = 0; k < 16; ++k) { const int r_ = rstart + (base_) + k; const int rc_ = r_ < 0 ? 0 : r_ >= SEQ ? SEQ - 1 : r_; raw[k] = *(const GAS unsigned long long*)(xb + (size_t)rc_ * 1024 + col); } } while (0)
    auto process = [&](const unsigned long long (&raw)[16], const int base) {
#pragma unroll
        for (int k = 0; k < 16; ++k) { const int r = rstart + base + k;
            const float rstd = __uint_as_float(__builtin_amdgcn_readlane(__float_as_uint(base + k < 64 ? rs0 : rs1), (base + k) & 63));
            const unsigned lo = (unsigned)raw[k], hi = (unsigned)(raw[k] >> 32);
            f32x4 a = (f32x4){bf_lo(lo), bf_hi(lo), bf_lo(hi), bf_hi(hi)} * rstd * gm + sh; if (r < 0 || r >= SEQ) a = (f32x4){0.f, 0.f, 0.f, 0.f};
            constexpr int W2 = 2 * HW; const int slot = k % W2;
            sum = sum + (a - ring[slot]); ring[slot] = a;
            const int t = r - HW + 1;
            if (t >= t0 && t < t0 + 64) { const int lo_t = t - HW < 0 ? 0 : t - HW, hi_t = t + HW > SEQ ? SEQ : t + HW; const float inv = 1.0f / (float)(hi_t - lo_t);
                const f32x4 c = ring[(k + W2 - HW + 1) % W2]; const f32x4 p = sum * inv - c;
                *(GAS unsigned long long*)(Pb + (size_t)t * 1024 + col) = (unsigned long long)pkbf(p.x, p.y) | ((unsigned long long)pkbf(p.z, p.w) << 32); } }
    };
    P9_LOAD(rawA, 0);
#pragma unroll 1
    for (int base = 0; base < 80; base += 32) {
        const bool more = base + 16 < 80;
        if (more) P9_LOAD(rawB, base + 16);
        process(rawA, base);
        if (more) { if (base + 32 < 80) P9_LOAD(rawA, base + 32); process(rawB, base + 16); }
    }
#undef P9_LOAD
}
__device__ __forceinline__ void p9_pool(const Args& a, const Frame& F) {
    const float* mod = (const float*)(F.ws + WS_MOD) + (size_t)9 * NMODV; const float* ng = a.in[6] + 2 * 1024;
    bf16* P = (bf16*)(F.ws + WS_A); const bf16* X = (const bf16*)(F.ws + WS_XR); const float* ssq = (const float*)(F.ws + WS_SSQ);
    const int gw = F.vcu * NWAVES + F.wave, NGW = F.G * NWAVES;
    { const int gt = blockIdx.x * (NWAVES * 64) + F.tid; if (gt < NB * 1024) ((float*)(F.ws + WS_GSC))[gt] = mod[(size_t)(gt >> 10) * NMODV + 2 * 1024 + (gt & 1023)] * a.in[17][gt & 1023]; }
    for (int task = gw; task < (ML / 64) * 4; task += NGW) {
        const int rb = task >> 2, g = task & 3, n0 = rb * 64, b = n0 / SEQ, t0 = n0 - b * SEQ; const int col = g * 256 + 4 * F.lane;
        const f32x4 gg = *(const f32x4*)(ng + col), sc = *(const f32x4*)(mod + (size_t)b * NMODV + 1024 + col), sh = *(const f32x4*)(mod + (size_t)b * NMODV + col); const f32x4 gm = gg * (sc + 1.0f);
        const bf16* xb = X + (size_t)b * SEQ * 1024; const float* sb = ssq + (size_t)b * SEQ * 16; bf16* Pb = P + (size_t)b * SEQ * 1024;
        if (g == 0) p9_task<1>(xb, sb, Pb, t0, gm, sh, col, F.lane); else if (g == 1) p9_task<2>(xb, sb, Pb, t0, gm, sh, col, F.lane);
        else if (g == 2) p9_task<4>(xb, sb, Pb, t0, gm, sh, col, F.lane); else p9_task<8>(xb, sb, Pb, t0, gm, sh, col, F.lane);
    }
}

__device__ __forceinline__ void p11a_router(const Args& a, const Frame& F) {
    LAS v4u* Wh = (LAS v4u*)(F.lds + RING_OFF); LAS v4u* Wl = Wh + 2048;
    LAS float* gms = (LAS float*)(F.lds + RING_OFF + 65536); LAS float* shs = gms + 1024;
    LAS int* e1s = (LAS int*)(F.lds + RING_OFF + 65536 + 8192); LAS int* e2s = e1s + 256;
    LAS unsigned long long* bm = (LAS unsigned long long*)(F.lds + RING_OFF + 65536 + 8192 + 2048);
    const float* mod = (const float*)(F.ws + WS_MOD) + (size_t)9 * NMODV; const float* ng = a.in[6] + 3 * 1024;
    const bf16* X = (const bf16*)(F.ws + WS_XR); bf16* A = (bf16*)(F.ws + WS_A);
    unsigned* hist = (unsigned*)(F.ws + WS_HIST); unsigned* toke = (unsigned*)(F.ws + WS_TOKE); unsigned* tokr = (unsigned*)(F.ws + WS_TOKR); float* tokp = (float*)(F.ws + WS_TOKP);
    for (int idx = F.tid; idx < 2048; idx += NWAVES * 64) { const int e = idx & 15, kg = (idx >> 4) & 3, st = idx >> 6; v4u h = (v4u){0u, 0u, 0u, 0u}, l = h;
        if (e < 8) { const float* wp = a.in[18] + (size_t)(32 * st + 8 * kg) * 8 + e;
#pragma unroll
            for (int i = 0; i < 4; ++i) { const float w0 = wp[(2 * i) * 8], w1 = wp[(2 * i + 1) * 8]; const unsigned hw = pkbf(w0, w1); h[i] = hw; l[i] = pkbf(w0 - bf_lo(hw), w1 - bf_hi(hw)); } }
        Wh[idx] = h; Wl[idx] = l; }
    float rb[8];
#pragma unroll
    for (int e = 0; e < 8; ++e) rb[e] = a.in[19][e];
    const int tr = F.lane & 15, g = F.lane >> 4;
    for (int ch = F.vcu; ch < ML / 256; ch += F.G) {
        const int b = (ch * 256) / SEQ;
        __syncthreads();
        for (int idx = F.tid; idx < 1024; idx += NWAVES * 64) { gms[idx] = ng[idx] * (mod[(size_t)b * NMODV + 4 * 1024 + idx] + 1.0f); shs[idx] = mod[(size_t)b * NMODV + 3 * 1024 + idx]; }
        __syncthreads();
#pragma unroll 1
        for (int grp = 0; grp < 2; ++grp) {
            const int tl = F.wave * 32 + grp * 16 + tr, n = ch * 256 + tl;
            const bf16* xr = X + (size_t)n * 1024 + 8 * g; bf16* ar = A + (size_t)n * 1024 + 8 * g;
            v4u raw[32];
#pragma unroll
            for (int st = 0; st < 32; ++st) raw[st] = *(const GAS v4u*)(xr + 32 * st);
            float ss = 0.f;
#pragma unroll
            for (int st = 0; st < 32; ++st)
#pragma unroll
                for (int i = 0; i < 4; ++i) { const float x0 = bf_lo(raw[st][i]), x1 = bf_hi(raw[st][i]); ss += x0 * x0 + x1 * x1; }
            ss += __shfl_xor(ss, 16); ss += __shfl_xor(ss, 32);
            const float rstd = rsqrtf(ss * (1.0f / 1024.0f) + EPS);
            f32x4 acc0 = (f32x4){0.f, 0.f, 0.f, 0.f}, acc1 = acc0, acc2 = acc0;
#pragma unroll
            for (int st = 0; st < 32; ++st) {
                const f32x4 g0 = *(const LAS f32x4*)(gms + 32 * st + 8 * g), g1 = *(const LAS f32x4*)(gms + 32 * st + 8 * g + 4), h0 = *(const LAS f32x4*)(shs + 32 * st + 8 * g), h1 = *(const LAS f32x4*)(shs + 32 * st + 8 * g + 4);
                v4u rw = raw[st]; asm volatile("" : "+v"(rw));
                const f32x4 fa = (f32x4){bf_lo(rw[0]), bf_hi(rw[0]), bf_lo(rw[1]), bf_hi(rw[1])} * rstd * g0 + h0, fb = (f32x4){bf_lo(rw[2]), bf_hi(rw[2]), bf_lo(rw[3]), bf_hi(rw[3])} * rstd * g1 + h1;
                v4u hi; hi[0] = pkbf(fa[0], fa[1]); hi[1] = pkbf(fa[2], fa[3]); hi[2] = pkbf(fb[0], fb[1]); hi[3] = pkbf(fb[2], fb[3]);
                *(GAS v4u*)(ar + 32 * st) = hi;
                v4u lo; lo[0] = pkbf(fa[0] - bf_lo(hi[0]), fa[1] - bf_hi(hi[0])); lo[1] = pkbf(fa[2] - bf_lo(hi[1]), fa[3] - bf_hi(hi[1])); lo[2] = pkbf(fb[0] - bf_lo(hi[2]), fb[1] - bf_hi(hi[2])); lo[3] = pkbf(fb[2] - bf_lo(hi[3]), fb[3] - bf_hi(hi[3]));
                const v4u wh = Wh[st * 64 + F.lane], wl = Wl[st * 64 + F.lane];
                acc0 = __builtin_amdgcn_mfma_f32_16x16x32_bf16(__builtin_bit_cast(pg8::bf16x8, wh), __builtin_bit_cast(pg8::bf16x8, hi), acc0, 0, 0, 0);
                acc1 = __builtin_amdgcn_mfma_f32_16x16x32_bf16(__builtin_bit_cast(pg8::bf16x8, wl), __builtin_bit_cast(pg8::bf16x8, hi), acc1, 0, 0, 0);
                acc2 = __builtin_amdgcn_mfma_f32_16x16x32_bf16(__builtin_bit_cast(pg8::bf16x8, wh), __builtin_bit_cast(pg8::bf16x8, lo), acc2, 0, 0, 0);
                if ((st & 1) == 1) __builtin_amdgcn_sched_barrier(0);
            }
            const f32x4 acc = acc0 + (acc1 + acc2);
            float lg[8];
#pragma unroll
            for (int e = 0; e < 4; ++e) { lg[e] = acc[e] + rb[e]; lg[4 + e] = __shfl_xor(acc[e], 16) + rb[4 + e]; }
            int i1 = 0; float v1 = lg[0];
#pragma unroll
            for (int e = 1; e < 8; ++e) if (lg[e] > v1) { v1 = lg[e]; i1 = e; }
            int i2 = -1; float v2 = -INFINITY;
#pragma unroll
            for (int e = 0; e < 8; ++e) if (e != i1 && lg[e] > v2) { v2 = lg[e]; i2 = e; }
            if (i2 < 0) i2 = (i1 + 1) & 7;
            const float p1 = 1.0f / (1.0f + __expf(v2 - v1));
            if (g == 0) { e1s[tl] = i1; e2s[tl] = i2; tokp[n] = p1; }
        }
        __syncthreads();
        int my1 = 0, my2 = 0;
        if (F.wave < 4) { my1 = e1s[F.tid]; my2 = e2s[F.tid];
#pragma unroll
            for (int e = 0; e < 8; ++e) { const unsigned long long m = __ballot(my1 == e || my2 == e); if (F.lane == 0) bm[e * 4 + F.wave] = m; } }
        __syncthreads();
        if (F.wave < 4) { const unsigned long long lt = (1ull << F.lane) - 1ull; unsigned r1 = 0, r2 = 0;
#pragma unroll
            for (int w = 0; w < 4; ++w) { const unsigned long long m1 = bm[my1 * 4 + w], m2 = bm[my2 * 4 + w];
                if (w < F.wave) { r1 += __popcll(m1); r2 += __popcll(m2); } else if (w == F.wave) { r1 += __popcll(m1 & lt); r2 += __popcll(m2 & lt); } }
            const int n = ch * 256 + F.tid; toke[n] = (unsigned)my1 | ((unsigned)my2 << 8); tokr[n] = r1 | (r2 << 16); }
        if (F.tid < 8) { unsigned c = 0;
#pragma unroll
            for (int w = 0; w < 4; ++w) c += __popcll(bm[F.tid * 4 + w]);
            hist[ch * 8 + F.tid] = c; }
        __syncthreads();
    }
}
__device__ __forceinline__ void moe_offsets(const Frame& F) {
    LAS unsigned* pre = (LAS unsigned*)(F.lds + RING_OFF); LAS unsigned* offs = (LAS unsigned*)(F.lds + LDSCTL_OFF); LAS unsigned* tot = offs + 16;
    const unsigned* hist = (const unsigned*)(F.ws + WS_HIST);
    for (int idx = F.tid; idx < 2048; idx += NWAVES * 64) pre[idx] = hist[idx];
    __syncthreads();
    if (F.tid < 8) { unsigned run = 0; for (int ch = 0; ch < 256; ++ch) { const unsigned h = pre[ch * 8 + F.tid]; pre[ch * 8 + F.tid] = run; run += h; } tot[F.tid] = run; }
    __syncthreads();
    if (F.tid == 0) { unsigned o = 0; for (int e = 0; e < 8; ++e) { offs[e] = o; o += (tot[e] + 255u) & ~255u; } offs[8] = o; }
    __syncthreads();
}
__device__ __forceinline__ void p11b_sort(const Args& a, const Frame& F) {
    moe_offsets(F);
    LAS unsigned* pre = (LAS unsigned*)(F.lds + RING_OFF); LAS unsigned* offs = (LAS unsigned*)(F.lds + LDSCTL_OFF); LAS unsigned* tot = offs + 16;
    const unsigned* toke = (const unsigned*)(F.ws + WS_TOKE); const unsigned* tokr = (const unsigned*)(F.ws + WS_TOKR); unsigned* toks = (unsigned*)(F.ws + WS_TOKS); unsigned* tokl = (unsigned*)(F.ws + WS_TOKL);
    if (blockIdx.x == 0) { for (int e = 0; e < NEXP; ++e) for (unsigned sl = offs[e] + tot[e] + F.tid; sl < offs[e + 1]; sl += NWAVES * 64) tokl[sl] = 0u; }
    for (int n = blockIdx.x * (NWAVES * 64) + F.tid; n < ML; n += F.G * NWAVES * 64) { const unsigned ee = toke[n], rr = tokr[n]; const int ch = n >> 8; const unsigned e1 = ee & 255u, e2 = ee >> 8;
        const unsigned s1 = offs[e1] + pre[ch * 8 + e1] + (rr & 0xffffu), s2 = offs[e2] + pre[ch * 8 + e2] + (rr >> 16);
        *(GAS unsigned long long*)(toks + 2 * n) = (unsigned long long)s1 | ((unsigned long long)s2 << 32); tokl[s1] = (unsigned)n; tokl[s2] = (unsigned)n; }
}
__device__ __forceinline__ void p14_final(const Args& a, const Frame& F) {
    const int gw = F.vcu * NWAVES + F.wave, NGW = F.G * NWAVES; const int rpw = (ML + NGW - 1) / NGW;
    const float* mod = (const float*)(F.ws + WS_MOD) + (size_t)9 * NMODV; const bf16* Y = (const bf16*)(F.ws + WS_R2);
    const unsigned* toks = (const unsigned*)(F.ws + WS_TOKS); const float* tokp = (const float*)(F.ws + WS_TOKP);
    f32x4 fg[4];
#pragma unroll
    for (int j = 0; j < 4; ++j) fg[j] = *(const f32x4*)(a.in[7] + 4 * F.lane + 256 * j);
    int cur_b = -1; f32x4 g2[4];
    int n1 = (gw + 1) * rpw; if (n1 > ML) n1 = ML;
    constexpr int NR = 4;
    for (int ng_ = gw * rpw; ng_ < n1; ng_ += NR) {
        f32x4 x[NR][4]; unsigned long long y1[NR][4], y2[NR][4]; float p1[NR];
#pragma unroll
        for (int q = 0; q < NR; ++q) { const int n = ng_ + q < n1 ? ng_ + q : n1 - 1; const unsigned s1 = toks[2 * n], s2 = toks[2 * n + 1]; p1[q] = tokp[n];
#pragma unroll
            for (int j = 0; j < 4; ++j) { const int col = 4 * F.lane + 256 * j; x[q][j] = ld_xr4((const bf16*)(F.ws + WS_XR) + (size_t)n * 1024 + col);
                y1[q][j] = *(const GAS unsigned long long*)(Y + (size_t)s1 * 1024 + col); y2[q][j] = *(const GAS unsigned long long*)(Y + (size_t)s2 * 1024 + col); } }
#pragma unroll
        for (int q = 0; q < NR; ++q) { const int n = ng_ + q; if (n < n1) { const int b = n / SEQ;
            if (b != cur_b) { cur_b = b;
#pragma unroll
                for (int j = 0; j < 4; ++j) g2[j] = *(const f32x4*)(mod + (size_t)b * NMODV + 5 * 1024 + 4 * F.lane + 256 * j); }
            const float pa = p1[q], pb = 1.0f - pa; f32x4 v[4]; float ss = 0.f;
#pragma unroll
            for (int j = 0; j < 4; ++j) { const unsigned a0 = (unsigned)y1[q][j], a1 = (unsigned)(y1[q][j] >> 32), b0 = (unsigned)y2[q][j], b1 = (unsigned)(y2[q][j] >> 32);
                f32x4 m; m.x = pa * bf_lo(a0) + pb * bf_lo(b0); m.y = pa * bf_hi(a0) + pb * bf_hi(b0); m.z = pa * bf_lo(a1) + pb * bf_lo(b1); m.w = pa * bf_hi(a1) + pb * bf_hi(b1);
                v[j] = x[q][j] + g2[j] * m; ss += (v[j].x * v[j].x + v[j].y * v[j].y) + (v[j].z * v[j].z + v[j].w * v[j].w); }
            const float rstd = rsqrtf(wave_sum(ss) * (1.0f / 1024.0f) + EPS);
#pragma unroll
            for (int j = 0; j < 4; ++j) *(GAS f32x4*)(a.out + (size_t)n * 1024 + 4 * F.lane + 256 * j) = v[j] * rstd * fg[j]; } }
    }
}
__device__ __forceinline__ void ctx_norm2(const Args& a, const Frame& F) {
    const int gw = F.vcu * NWAVES + F.wave, NGW = F.G * NWAVES;
    const float* modc = (const float*)(F.ws + WS_MOD) + (size_t)8 * NMODV; const float* ng = a.in[6] + 1024;
    const bf16* X = (const bf16*)(F.ws + WS_XRC); bf16* A = (bf16*)(F.ws + WS_A1C);
    for (int R = gw; R < NB * CTXL; R += NGW) {
        f32x4 v[4]; float ss = 0.f;
#pragma unroll
        for (int j = 0; j < 4; ++j) { v[j] = ld_xr4(X + (size_t)R * 1024 + 4 * F.lane + 256 * j); ss += (v[j].x * v[j].x + v[j].y * v[j].y) + (v[j].z * v[j].z + v[j].w * v[j].w); }
        const float rstd = rsqrtf(wave_sum(ss) * (1.0f / 1024.0f) + EPS);
#pragma unroll
        for (int j = 0; j < 4; ++j) { const int col = 4 * F.lane + 256 * j; const f32x4 g = *(const f32x4*)(ng + col), sc = *(const f32x4*)(modc + 4 * 1024 + col), sh = *(const f32x4*)(modc + 3 * 1024 + col);
            const f32x4 o = v[j] * rstd * (g * (sc + 1.0f)) + sh;
            *(GAS unsigned long long*)(A + (size_t)R * 1024 + col) = (unsigned long long)pkbf(o.x, o.y) | ((unsigned long long)pkbf(o.z, o.w) << 32); }
    }
}
__device__ __forceinline__ void ctx_ffn_residual(const Args& a, const Frame& F) {
    const int gw = F.vcu * NWAVES + F.wave, NGW = F.G * NWAVES;
    const float* g2c = (const float*)(F.ws + WS_MOD) + (size_t)8 * NMODV + 5 * 1024;
    bf16* X = (bf16*)(F.ws + WS_XRC); const bf16* Y = (const bf16*)(F.ws + WS_YC);
    for (int R = gw; R < NB * CTXL; R += NGW) { const int b = R >> 8, r = R & 255;
#pragma unroll
        for (int j = 0; j < 4; ++j) { const int col = 4 * F.lane + 256 * j; const f32x4 x = ld_xr4(X + (size_t)R * 1024 + col), y0 = ld_xr4(Y + ((size_t)(2 * b) * 256 + r) * 1024 + col), y1 = ld_xr4(Y + ((size_t)(2 * b + 1) * 256 + r) * 1024 + col);
            const f32x4 o = x + *(const f32x4*)(g2c + col) * (y0 + y1);
            *(GAS unsigned long long*)(X + (size_t)R * 1024 + col) = (unsigned long long)pkbf(o.x, o.y) | ((unsigned long long)pkbf(o.z, o.w) << 32); }
    }
}
__global__ void __launch_bounds__(NWAVES * 64, 2) fwd_kernel(Args args) {
    extern __shared__ __attribute__((aligned(16))) unsigned char lds[];
    Frame F;
    F.lds = (LAS unsigned char*)lds;
    F.MISC = (volatile LAS unsigned*)(F.lds + MISC_OFF);
    F.tid = threadIdx.x; F.lane = F.tid & 63; F.wave = __builtin_amdgcn_readfirstlane(F.tid >> 6);
    F.G = gridDim.x; { const int bx = blockIdx.x; F.vcu = (F.G % 8 == 0) ? (bx % 8) * (F.G / 8) + bx / 8 : bx; }
    F.ws = args.ws; F.ctl = (gu32*)(args.ws + WS_CTL);
    for (int u = F.tid; u < (LDS_BYTES - LDSCTL_OFF) / 4; u += NWAVES * 64) ((LAS unsigned*)(F.lds + LDSCTL_OFF))[u] = 0u;
    __syncthreads();
    XcdBarrier bar; bar.bar = (unsigned*)(F.ctl + CW_BAR); bar.x = 0; bar.st = nullptr;
    if (!MK_PER_PHASE) bar = xcd_barrier_post((unsigned*)(F.ctl + CW_BAR), F.MISC + 8);
    const int lo = args.ph_lo, hi = args.ph_hi;
#define IN(k) (lo <= (k) && (k) < hi)
#define SEAM(k) do { if (IN(k) && IN((k) + 1)) xcd_barrier(bar); } while (0)
    bf16* const WA = (bf16*)(F.ws + WS_A); bf16* const R1 = (bf16*)(F.ws + WS_R1); bf16* const R2 = (bf16*)(F.ws + WS_R2); bf16* const XR = (bf16*)(F.ws + WS_XR);
    const float* const mod0 = (const float*)(F.ws + WS_MOD); const float* const mod1 = mod0 + (size_t)9 * NMODV;

#define PH(k, first, body) do { if (IN(k)) { RETID(); if (PROBE_DUP == (k)) { first; xcd_barrier(bar); } body; } SEAM(k); } while (0)
#define RETID() do { int t_ = threadIdx.x; asm volatile("" : "+v"(t_)); F.tid = t_; F.lane = t_ & 63; } while (0)
    constexpr int NS = PROBE_NOSTORE;
    PH(0, p0_prologue(args, F), p0_prologue(args, F));
    PH(1, norm_mod_phase<0>(args, F, F.vcu, F.G), norm_mod_phase<0>(args, F, F.vcu, F.G));
#define P2BODY(ns) { pg8::Gemm g{WA, (const bf16*)(F.ws + WS_WIN), 1024, 1024, 1024, 0, 0, nullptr}; InProjOrder S{F.G, (int)blockIdx.x}; pg8::EpiInProj E{R1, ZP, ns, args.in[9], args.in[10], (const float*)(F.ws + WS_ROPE), QSCALE}; \
        pg8::gemm_phase<pg8::EpiInProj, InProjOrder, true, true>(F.lds + RING_OFF, g, S, E); }
    PH(2, P2BODY(NS), P2BODY(0));
    PH(3, (void)0, p3_postproc(args, F));
    float smax; { const float gq = fabsf(args.in[9][F.lane]), gk = fabsf(args.in[10][F.lane]); float mq = gq, mk = gk;
#pragma unroll
        for (int o = 1; o < 64; o <<= 1) { mq = fmaxf(mq, __shfl_xor(mq, o)); mk = fmaxf(mk, __shfl_xor(mk, o)); }
        smax = 64.0f * QSCALE * mq * mk * 1.03f + 0.5f; smax = __builtin_amdgcn_readfirstlane(smax); }
#define P4BODY(Ob) { if (smax <= 40.0f) attn_body::attn_phase<8, true>((char*)lds + RING_OFF, (attn_body::bf16*)R1, (attn_body::bf16*)(Ob), F.G, F.vcu, smax, args.in[9], (const float*)(F.ws + WS_ROPE)); \
        else attn_body::attn_phase<8, false>((char*)lds + RING_OFF, (attn_body::bf16*)R1, (attn_body::bf16*)(Ob), F.G, F.vcu, 0.f, args.in[9], (const float*)(F.ws + WS_ROPE)); }
    PH(4, P4BODY(R2), P4BODY(R1));
#define P5BODY(ns) { pg8::Gemm g{R1, (const bf16*)(F.ws + WS_WOUT), 1024, ZP, 1024, 0, 0, nullptr}; GridOrder S{256, 4, F.G, (int)blockIdx.x, true}; pg8::EpiResB<true> E{args.in[0], XR, mod0 + 2 * 1024, NMODV, nullptr, ns, nullptr}; \
        pg8::gemm_phase<pg8::EpiResB<true>, GridOrder, true, true>(F.lds + RING_OFF, g, S, E); }
    PH(5, P5BODY(NS), P5BODY(0));
#define P6BODY() { const int ncw = (F.G + 7) / 8 < 32 ? (F.G + 7) / 8 : 32; const bool cw = (F.vcu & 7) == 0 && (F.vcu >> 3) < ncw; \
        if (cw) { pg8::Gemm g{R1, (const bf16*)(F.ws + WS_WOUT), 1024, ZP, 1024, 0, 0, nullptr}; CtxOrder S{4, ncw, F.vcu >> 3, true}; pg8::EpiResB<true> E{args.in[2], (bf16*)(F.ws + WS_XRC), mod0 + (size_t)8 * NMODV + 2 * 1024, 0, nullptr, 0, nullptr}; \
            pg8::gemm_phase<pg8::EpiResB<true>, CtxOrder, true, true>(F.lds + RING_OFF, g, S, E); } \
        else { const int below = (F.vcu + 7) / 8 < ncw ? (F.vcu + 7) / 8 : ncw; norm_mod_phase<1>(args, F, F.vcu - below, F.G - ncw); } }
    PH(6, P6BODY(), P6BODY());
#ifndef PV_ALIGN
#define PV_ALIGN true
#endif
#ifndef PV_SP2
#define PV_SP2 true
#endif
#define P7BODY(ns, AL, SP) { pg8::Gemm g{WA, (const bf16*)(F.ws + WS_WGU), 1024, 1024, 1024, 0, 0, nullptr}; GridOrder S{256, 22, F.G, (int)blockIdx.x, false}; pg8::EpiSwiGLU E{R1, DFF, ns}; \
        pg8::gemm_phase<pg8::EpiSwiGLU, GridOrder, AL, SP, true>(F.lds + RING_OFF, g, S, E); }
    PH(7, P7BODY(NS, PV_ALIGN, PV_SP2), P7BODY(0, true, true));
#define P8BODY(ns) { pg8::Gemm g{R1, (const bf16*)(F.ws + WS_WD), DFF, 64, DFF, 0, 0, nullptr}; GridOrder S{256, 4, F.G, (int)blockIdx.x, false}; pg8::EpiResB<false> E{XR, XR, mod0 + 5 * 1024, NMODV, nullptr, ns, (float*)(F.ws + WS_SSQ)}; \
        pg8::gemm_phase<pg8::EpiResB<false>, GridOrder, true, true, true>(F.lds + RING_OFF, g, S, E); }
    PH(8, P8BODY(1), P8BODY(0));
    PH(9, p9_pool(args, F), { p9_pool(args, F); ctx_norm2(args, F); });
#define P10BODY(ns) { pg8::Gemm g{WA, (const bf16*)(F.ws + WS_WP), 256, 1024, 256, 512, 0, nullptr}; GridOrder S{256, 4, F.G, (int)blockIdx.x, false}; pg8::EpiResB<false> E{XR, XR, (const float*)(F.ws + WS_GSC), 1024, nullptr, ns, nullptr}; \
        pg8::gemm_phase<pg8::EpiResB<false>, GridOrder, true, true>(F.lds + RING_OFF, g, S, E); }
    PH(10, P10BODY(1), P10BODY(0));
    PH(11, p11a_router(args, F), p11a_router(args, F));
    PH(12, p11b_sort(args, F), p11b_sort(args, F));
#define P13BODY(ns) { moe_offsets(F); const LAS unsigned* offs = (const LAS unsigned*)(F.lds + LDSCTL_OFF); int ts[9]; \
        _Pragma("unroll") for (int e = 0; e < 9; ++e) ts[e] = __builtin_amdgcn_readfirstlane((int)(offs[e] >> 8)); \
        pg8::Gemm g{WA, (const bf16*)(F.ws + WS_WEGU), 1024, 1024, 1024, 0, (size_t)2 * DFE * 1024 * 2, (const unsigned*)(F.ws + WS_TOKL)}; MoeOrder S{ts[8], 11, F.G, (int)blockIdx.x, ts[1], ts[2], ts[3], ts[4], ts[5], ts[6], ts[7]}; pg8::EpiSwiGLU E{R1, DFE, ns}; \
        pg8::gemm_phase<pg8::EpiSwiGLU, MoeOrder, true, true, false, true>(F.lds + RING_OFF, g, S, E); \
          \
        { const int c0 = (int)(((long)ts[8] * 11) % F.G); pg8::Gemm gc{(const bf16*)(F.ws + WS_A1C), (const bf16*)(F.ws + WS_WGU), 1024, 1024, 1024, 0, 0, nullptr}; CtxOrder Sc{22, F.G, ((int)blockIdx.x - c0 + F.G) % F.G, false}; pg8::EpiSwiGLU Ec{(bf16*)(F.ws + WS_HC), DFF, ns}; \
          pg8::gemm_phase<pg8::EpiSwiGLU, CtxOrder, true, true>(F.lds + RING_OFF, gc, Sc, Ec); } }
    PH(13, P13BODY(NS), P13BODY(0));
#define P14BODY(ns) { moe_offsets(F); const LAS unsigned* offs = (const LAS unsigned*)(F.lds + LDSCTL_OFF); int ts[9]; \
        _Pragma("unroll") for (int e = 0; e < 9; ++e) ts[e] = __builtin_amdgcn_readfirstlane((int)(offs[e] >> 8)); \
        pg8::Gemm g{R1, (const bf16*)(F.ws + WS_WED), DFE, 64, DFE, 0, (size_t)1024 * DFE * 2, nullptr}; MoeOrder S{ts[8], 4, F.G, (int)blockIdx.x, ts[1], ts[2], ts[3], ts[4], ts[5], ts[6], ts[7]}; pg8::EpiBf16 E{R2, 1024, ns}; \
        pg8::gemm_phase<pg8::EpiBf16, MoeOrder, true, true, true>(F.lds + RING_OFF, g, S, E); \
          \
        { const int c0 = (int)(((long)ts[8] * 4) % F.G); pg8::Gemm gc{(const bf16*)(F.ws + WS_HC), (const bf16*)(F.ws + WS_WD), DFF / 2, 64, DFF, 0, (size_t)(DFF / 2) * 2, nullptr}; CtxSplitKOrder Sc{F.G, ((int)blockIdx.x - c0 + F.G) % F.G}; \
          pg8::EpiBf16 Ec{(bf16*)(F.ws + WS_YC), 1024, ns}; \
          pg8::gemm_phase<pg8::EpiBf16, CtxSplitKOrder, true, true, true>(F.lds + RING_OFF, gc, Sc, Ec); } }
    PH(14, P14BODY(NS), P14BODY(0));
    if (IN(15)) { RETID(); p14_final(args, F); ctx_ffn_residual(args, F); }
#undef PH
#undef IN
#undef SEAM
}

extern "C" void kernel_launch(void* const* d_in, const int* in_sizes, int n_in, void* d_out, int out_size, void* d_ws, size_t ws_size, hipStream_t stream) {
    static int grid = 0;
    if (grid == 0) {
        if (n_in != 23 || in_sizes[0] != ML * DMODEL || out_size != ML * DMODEL || ws_size < WS_END) { fprintf(stderr, "kernel_launch: unexpected shapes / workspace (n_in %d, in0 %d, out %d, ws %zu); nothing launched\n", n_in, n_in > 0 ? in_sizes[0] : -1, out_size, ws_size); grid = -1; return; }
        int dev = 0, cus = 0, per_cu = 0;
        if (hipGetDevice(&dev) != hipSuccess || hipDeviceGetAttribute(&cus, hipDeviceAttributeMultiprocessorCount, dev) != hipSuccess) { fprintf(stderr, "kernel_launch: hipGetDevice / hipDeviceGetAttribute failed; nothing launched\n"); grid = -1; return; }
        if (hipFuncSetAttribute((const void*)fwd_kernel, hipFuncAttributeMaxDynamicSharedMemorySize, LDS_BYTES) != hipSuccess) { fprintf(stderr, "kernel_launch: hipFuncSetAttribute failed; nothing launched\n"); grid = -1; return; }
        if (hipOccupancyMaxActiveBlocksPerMultiprocessor(&per_cu, (const void*)fwd_kernel, NWAVES * 64, LDS_BYTES) != hipSuccess || per_cu < 1) { fprintf(stderr, "kernel_launch: occupancy query reports %d workgroups per CU\n", per_cu); }
        (void)hipGetLastError();
        grid = cus;
    }
    if (grid < 0) return;
    if (hipMemsetAsync((char*)d_ws + WS_CTL, 0, CTL_ZERO_BYTES, stream) != hipSuccess) { fprintf(stderr, "kernel_launch: hipMemsetAsync failed\n"); return; }
    Args a{};
    for (int i = 0; i < 23; ++i) a.in[i] = (const float*)d_in[i];
    a.out = (float*)d_out; a.ws = (unsigned char*)d_ws;
#if MK_PER_PHASE
    for (int p = 0; p < NPHASE; ++p) { a.ph_lo = p; a.ph_hi = p + 1; hipLaunchKernelGGL(fwd_kernel, dim3(grid), dim3(NWAVES * 64), LDS_BYTES, stream, a); }
#else
    a.ph_lo = 0; a.ph_hi = NPHASE;
    hipLaunchKernelGGL(fwd_kernel, dim3(grid), dim3(NWAVES * 64), LDS_BYTES, stream, a);
#endif
    const hipError_t le = hipPeekAtLastError();
    if (le != hipSuccess) fprintf(stderr, "kernel_launch: launch failed: %s\n", hipGetErrorName(le));
}
```

```cpp
#include <hip/hip_runtime.h>
#include <hip/hip_bf16.h>
#include <cstdio>
#include <cstdint>
#include <cmath>
namespace pg8 {
#define PG8_LAS __attribute__((address_space(3)))
typedef unsigned short bf16_t;
typedef short bf16x8 __attribute__((ext_vector_type(8)));
typedef float f32x4 __attribute__((ext_vector_type(4)));
typedef unsigned u32x4 __attribute__((ext_vector_type(4)));
constexpr int BM = 256, BK = 64, HALF = 128, HTB = HALF * BK * 2  , STAGE_BYTES = 8 * HTB, NXCD = 8, WGM = 8;

__host__ __device__ __forceinline__ int lds_byte(int r, int c) { const int st = (r >> 4) * 2 + (c >> 5), rr = r & 15, cc = c & 31, ob = rr * 64 + cc * 2; return st * 1024 + (ob ^ (((ob >> 9) & 1) << 5)); }
__host__ __device__ __forceinline__ void stage_rc(int b, int& R, int& C) { const int st = b / 1024, sb = b % 1024, swz = sb ^ (((sb >> 9) & 1) << 5); R = (st >> 1) * 16 + swz / 64; C = (st & 1) * 32 + (swz % 64) / 2; }
__host__ __device__ __forceinline__ int perm32(int rho) { const int n = rho >> 4, i = rho & 15; return 8 * (i >> 2) + 4 * n + (i & 3); }

struct Unit { int pm, pn, e, om; };
struct Gemm { const bf16_t* A; const bf16_t* Bt; int K, lda, ldb; size_t a_pn_bytes, b_e_bytes; const unsigned* rows; };

__host__ __device__ __forceinline__ void tile_map(int L, int nM, int nN, int& pm, int& pn) {
    const int nwg = nM * nN; int wgid = L; { const int q = nwg / NXCD, r = nwg % NXCD, xcd = wgid % NXCD, off = wgid / NXCD; wgid = (xcd < r ? xcd * (q + 1) : r * (q + 1) + (xcd - r) * q) + off; }
    const int nig = WGM * nN, gid = wgid / nig, fm = gid * WGM, gsz = (nM - fm) < WGM ? (nM - fm) : WGM;
    pm = fm + ((wgid % nig) % gsz); pn = (wgid % nig) / gsz;
}

template <class V> __device__ __forceinline__ void st16(void* p, const V v) { *(V*)p = v; }
__device__ __forceinline__ unsigned cvt_pk_bf16(float lo, float hi) { unsigned r; asm volatile("v_cvt_pk_bf16_f32 %0, %1, %2" : "=v"(r) : "v"(lo), "v"(hi)); return r; }

struct EpiBf16 {
    static constexpr bool PERM = true, AFTER_DRAIN = false;
    bf16_t* O; int ldc; int nostore;
    __device__ __forceinline__ void operator()(const f32x4 (&acc)[2][2][4][2], const Unit& u, int wr, int wc, int fr, int fq) const {
        const int row0 = u.om * BM + wr * 64 + fr; const int col0 = u.pn * BM + wc * 32 + 8 * fq;
#pragma unroll
        for (int ai = 0; ai < 2; ++ai)
#pragma unroll
            for (int m = 0; m < 4; ++m) { bf16_t* rowp = O + (size_t)(row0 + ai * HALF + m * 16) * ldc + col0;
#pragma unroll
                for (int bj = 0; bj < 2; ++bj) { const f32x4 v0 = acc[ai][bj][m][0], v1 = acc[ai][bj][m][1];
                    u32x4 w; w.x = cvt_pk_bf16(v0[0], v0[1]); w.y = cvt_pk_bf16(v0[2], v0[3]); w.z = cvt_pk_bf16(v1[0], v1[1]); w.w = cvt_pk_bf16(v1[2], v1[3]);
                    if (nostore) asm volatile("" :: "v"(w)); else st16(rowp + bj * HALF, w); } }
    }
};
struct EpiInProj {
    static constexpr bool PERM = true, AFTER_DRAIN = false;
    bf16_t* O; int ldc; int nostore; const float* qg; const float* kg; const float* ropeT; float qscale;
    __device__ __forceinline__ void operator()(const f32x4 (&acc)[2][2][4][2], const Unit& u, int wr, int wc, int fr, int fq) const {
        const int row0 = u.om * BM + wr * 64 + fr;
        if (u.pn < 5) { const int col0 = u.pn * BM + wc * 64 + 8 * fq;
            const bool isq = u.pn < 2, isk = u.pn == 4 && wc < 2;
            if (isq || isk) {
                const float* gp = (isq ? qg : kg) + 4 * fq; const float sc = isq ? qscale : 1.0f;
                f32x4 g[2][2];
#pragma unroll
                for (int bj = 0; bj < 2; ++bj)
#pragma unroll
                    for (int n = 0; n < 2; ++n) g[bj][n] = *(const f32x4*)(gp + bj * 32 + n * 16) * sc;
                const int tt = u.om % 33; const bool lat = tt != 0; const int t0 = (tt - 1) * BM + wr * 64 + fr;
#pragma unroll
                for (int ai = 0; ai < 2; ++ai)
#pragma unroll
                    for (int m = 0; m < 4; ++m) { bf16_t* rowp = O + (size_t)(row0 + ai * HALF + m * 16) * ldc + col0;
                        float ss = 0.f;
#pragma unroll
                        for (int bj = 0; bj < 2; ++bj)
#pragma unroll
                            for (int n = 0; n < 2; ++n) { const f32x4 v = acc[ai][bj][m][n]; ss += (v[0] * v[0] + v[1] * v[1]) + (v[2] * v[2] + v[3] * v[3]); }
                        ss += __shfl_xor(ss, 16); ss += __shfl_xor(ss, 32);
                        const float rstd = rsqrtf(ss * (1.0f / 64.0f) + 1e-6f);
                        const int t = t0 + ai * HALF + m * 16;
#pragma unroll
                        for (int bj = 0; bj < 2; ++bj) { f32x4 x1 = acc[ai][bj][m][0] * rstd * g[bj][0], x2 = acc[ai][bj][m][1] * rstd * g[bj][1];
                            if (lat) { const int pos = bj ? 128 + (t & 63) : (t >> 6); const float* tp = ropeT + ((size_t)pos * 16 + 4 * fq) * 2; const f32x4 cs0 = *(const f32x4*)tp, cs1 = *(const f32x4*)(tp + 4);
                                const f32x4 c = (f32x4){cs0[0], cs0[2], cs1[0], cs1[2]}, sn = (f32x4){cs0[1], cs0[3], cs1[1], cs1[3]};
                                const f32x4 y1 = x1 * c - x2 * sn, y2 = x2 * c + x1 * sn; x1 = y1; x2 = y2; }
                            u32x4 w; w.x = cvt_pk_bf16(x1[0], x1[1]); w.y = cvt_pk_bf16(x1[2], x1[3]); w.z = cvt_pk_bf16(x2[0], x2[1]); w.w = cvt_pk_bf16(x2[2], x2[3]);
                            if (nostore) asm volatile("" :: "v"(w)); else st16(rowp + bj * 32, w); } }
            } else {
#pragma unroll
                for (int ai = 0; ai < 2; ++ai)
#pragma unroll
                    for (int m = 0; m < 4; ++m) { bf16_t* rowp = O + (size_t)(row0 + ai * HALF + m * 16) * ldc + col0;
#pragma unroll
                        for (int bj = 0; bj < 2; ++bj) { const f32x4 v0 = acc[ai][bj][m][0], v1 = acc[ai][bj][m][1];
                            u32x4 w; w.x = cvt_pk_bf16(v0[0], v0[1]); w.y = cvt_pk_bf16(v0[2], v0[3]); w.z = cvt_pk_bf16(v1[0], v1[1]); w.w = cvt_pk_bf16(v1[2], v1[3]);
                            if (nostore) asm volatile("" :: "v"(w)); else st16(rowp + bj * 32, w); } }
            }
        } else { const int col0 = 1280 + (u.pn - 5) * HALF + wc * 32 + 8 * fq;
#pragma unroll
            for (int ai = 0; ai < 2; ++ai)
#pragma unroll
                for (int m = 0; m < 4; ++m) { bf16_t* rowp = O + (size_t)(row0 + ai * HALF + m * 16) * ldc + col0;
                    const f32x4 p0 = acc[ai][0][m][0] * acc[ai][1][m][0], p1 = acc[ai][0][m][1] * acc[ai][1][m][1];
                    u32x4 w; w.x = cvt_pk_bf16(p0[0], p0[1]); w.y = cvt_pk_bf16(p0[2], p0[3]); w.z = cvt_pk_bf16(p1[0], p1[1]); w.w = cvt_pk_bf16(p1[2], p1[3]);
                    if (nostore) asm volatile("" :: "v"(w)); else st16(rowp, w); } }
    }
};
struct EpiSwiGLU {
    static constexpr bool PERM = true, AFTER_DRAIN = false;
    bf16_t* O; int ldc; int nostore;
    __device__ __forceinline__ static f32x4 silu_mul4(const f32x4 g, const f32x4 u) { const f32x4 t = g; f32x4 e;     e[0] = __builtin_amdgcn_exp2f(t[0]); e[1] = __builtin_amdgcn_exp2f(t[1]); e[2] = __builtin_amdgcn_exp2f(t[2]); e[3] = __builtin_amdgcn_exp2f(t[3]);
        const f32x4 d = e + 1.0f; f32x4 r; r[0] = __builtin_amdgcn_rcpf(d[0]); r[1] = __builtin_amdgcn_rcpf(d[1]); r[2] = __builtin_amdgcn_rcpf(d[2]); r[3] = __builtin_amdgcn_rcpf(d[3]); return (g * u) * r; }
    __device__ __forceinline__ void operator()(const f32x4 (&acc)[2][2][4][2], const Unit& u, int wr, int wc, int fr, int fq) const {
        const int col0 = u.pn * HALF + wc * 32 + 8 * fq; const unsigned off0 = ((unsigned)((u.om * (ldc >> 6) + (col0 >> 6)) * BM + wr * 64 + fr) * 64u + (unsigned)(col0 & 63)) * 2u;
#pragma unroll
        for (int ai = 0; ai < 2; ++ai)
#pragma unroll
            for (int m = 0; m < 4; ++m) { bf16_t* rowp = (bf16_t*)((char*)O + (off0 + (unsigned)((ai * HALF + m * 16) * 128)));
                const f32x4 h0 = silu_mul4(acc[ai][0][m][0], acc[ai][1][m][0]), h1 = silu_mul4(acc[ai][0][m][1], acc[ai][1][m][1]);
                u32x4 w; w.x = cvt_pk_bf16(h0[0], h0[1]); w.y = cvt_pk_bf16(h0[2], h0[3]); w.z = cvt_pk_bf16(h1[0], h1[1]); w.w = cvt_pk_bf16(h1[2], h1[3]);
                if (nostore == 1) asm volatile("" :: "v"(w)); else if (nostore == 2) __builtin_nontemporal_store(w, (u32x4*)rowp); else if (nostore == 3) *(u32x4*)rowp = w; else st16(rowp, w); }
    }
};
template <bool BASE_F32> struct EpiResB {
    static constexpr bool PERM = true, AFTER_DRAIN = false;
    const void* base; bf16_t* out; const float* gate; int gate_bstride; const float* cscale; int nostore; float* ssq;
    __device__ __forceinline__ void finish(const f32x4 (&acc)[2][2][4][2], const Unit& u, int ai, int m, const f32x4 (&gv)[2][2], const f32x4 (&b)[2][2], int row0, int col0, int wc, int fq) const {
        const size_t off = (size_t)(row0 + ai * HALF + m * 16) * 1024 + col0; float sq = 0.f;
#pragma unroll
        for (int bj = 0; bj < 2; ++bj) { const f32x4 o0 = b[bj][0] + gv[bj][0] * acc[ai][bj][m][0], o1 = b[bj][1] + gv[bj][1] * acc[ai][bj][m][1];
            u32x4 ow; ow.x = cvt_pk_bf16(o0[0], o0[1]); ow.y = cvt_pk_bf16(o0[2], o0[3]); ow.z = cvt_pk_bf16(o1[0], o1[1]); ow.w = cvt_pk_bf16(o1[2], o1[3]);
            sq += (o0[0] * o0[0] + o0[1] * o0[1]) + (o0[2] * o0[2] + o0[3] * o0[3]) + (o1[0] * o1[0] + o1[1] * o1[1]) + (o1[2] * o1[2] + o1[3] * o1[3]);
            if (nostore) asm volatile("" :: "v"(ow)); else *(u32x4*)(out + off + bj * HALF) = ow; }
        if (ssq) { sq += __shfl_xor(sq, 16); sq += __shfl_xor(sq, 32); if (fq == 0 && !nostore) ssq[(size_t)(row0 + ai * HALF + m * 16) * 16 + u.pn * 4 + wc] = sq; }
    }
    __device__ __forceinline__ void operator()(const f32x4 (&acc)[2][2][4][2], const Unit& u, int wr, int wc, int fr, int fq) const {
        const int row0 = u.om * BM + wr * 64 + fr, col0 = u.pn * BM + wc * 32 + 8 * fq; const int b = u.om >> 5;
        f32x4 gv[2][2];
#pragma unroll
        for (int bj = 0; bj < 2; ++bj)
#pragma unroll
            for (int n = 0; n < 2; ++n) { gv[bj][n] = *(const f32x4*)(gate + (size_t)b * gate_bstride + col0 + bj * HALF + n * 4); if (cscale) gv[bj][n] = gv[bj][n] * *(const f32x4*)(cscale + col0 + bj * HALF + n * 4); }
        if constexpr (BASE_F32) {
#pragma unroll
            for (int ai = 0; ai < 2; ++ai) { f32x4 bb[4][2][2];
#pragma unroll
                for (int m = 0; m < 4; ++m) { const size_t off = (size_t)(row0 + ai * HALF + m * 16) * 1024 + col0;
#pragma unroll
                    for (int bj = 0; bj < 2; ++bj) { bb[m][bj][0] = *(const f32x4*)((const float*)base + off + bj * HALF); bb[m][bj][1] = *(const f32x4*)((const float*)base + off + bj * HALF + 4); } }
                asm volatile("" ::: "memory");
#pragma unroll
                for (int m = 0; m < 4; ++m) finish(acc, u, ai, m, gv, bb[m], row0, col0, wc, fq);
                asm volatile("" ::: "memory"); }
        } else {
#pragma unroll
            for (int ai = 0; ai < 2; ++ai) { u32x4 ww[4][2];
#pragma unroll
                for (int m = 0; m < 4; ++m) { const size_t off = (size_t)(row0 + ai * HALF + m * 16) * 1024 + col0;
#pragma unroll
                    for (int bj = 0; bj < 2; ++bj) ww[m][bj] = *(const u32x4*)((const bf16_t*)base + off + bj * HALF); }
                asm volatile("" ::: "memory");
#pragma unroll
                for (int m = 0; m < 4; ++m) { f32x4 bb[2][2];
#pragma unroll
                    for (int bj = 0; bj < 2; ++bj) { const u32x4 w = ww[m][bj];
                        bb[bj][0] = (f32x4){__uint_as_float(w.x << 16), __uint_as_float(w.x & 0xffff0000u), __uint_as_float(w.y << 16), __uint_as_float(w.y & 0xffff0000u)};
                        bb[bj][1] = (f32x4){__uint_as_float(w.z << 16), __uint_as_float(w.z & 0xffff0000u), __uint_as_float(w.w << 16), __uint_as_float(w.w & 0xffff0000u)}; }
                    finish(acc, u, ai, m, gv, bb, row0, col0, wc, fq); }
                asm volatile("" ::: "memory"); }
        }
    }
};
struct EpiRes {
    static constexpr bool PERM = false, AFTER_DRAIN = false;
    const float* base; float* out; const float* gate; int gate_bstride; const float* cscale; int nostore;
    __device__ __forceinline__ void operator()(const f32x4 (&acc)[2][2][4][2], const Unit& u, int wr, int wc, int fr, int fq) const {
        const int row0 = u.om * BM + wr * 64 + fr, col0 = u.pn * BM + wc * 32 + 4 * fq; const int b = u.om >> 5;
        f32x4 gv[2][2];
#pragma unroll
        for (int bj = 0; bj < 2; ++bj)
#pragma unroll
            for (int n = 0; n < 2; ++n) { gv[bj][n] = *(const f32x4*)(gate + (size_t)b * gate_bstride + col0 + bj * HALF + n * 16); if (cscale) gv[bj][n] = gv[bj][n] * *(const f32x4*)(cscale + col0 + bj * HALF + n * 16); }
#pragma unroll
        for (int ai = 0; ai < 2; ++ai)
#pragma unroll
            for (int m = 0; m < 4; ++m) { const size_t off = (size_t)(row0 + ai * HALF + m * 16) * 1024 + col0;
#pragma unroll
                for (int bj = 0; bj < 2; ++bj)
#pragma unroll
                    for (int n = 0; n < 2; ++n) { const f32x4 bs = *(const f32x4*)(base + off + bj * HALF + n * 16); const f32x4 ov = bs + gv[bj][n] * acc[ai][bj][m][n]; if (nostore) asm volatile("" :: "v"(ov)); else st16(out + off + bj * HALF + n * 16, ov); }
                if (m & 1) asm volatile("" ::: "memory"); }
    }
};
template <class Epi, class Sched, bool ALIGN_EPI = false, bool SP2 = false, bool ATILED = false, bool AGATHER = false>
__device__ __forceinline__ void gemm_phase(PG8_LAS unsigned char* lds, const Gemm g, const Sched& S, const Epi& E) {
    const int tid = threadIdx.x, wid = __builtin_amdgcn_readfirstlane(tid >> 6), lane = tid & 63, wr = wid >> 2, wc = wid & 3, fr = lane & 15, fq = lane >> 4;
    const int K = g.K, nt = K / BK;
    unsigned voffA[2], voffB[2];
#pragma unroll
    for (int i = 0; i < 2; ++i) { int R, C; stage_rc(tid * 16 + i * 8192, R, C); const int Rb = Epi::PERM ? ((R & ~31) + perm32(R & 31)) : R;
        voffA[i] = (unsigned)(R * (ATILED ? 64 : g.lda) + C) * 2u; voffB[i] = (unsigned)(Rb * g.ldb + C) * 2u; }
    unsigned vA0[2], vA1[2], vN0[2], vN1[2];
#pragma unroll
    for (int i = 0; i < 2; ++i) { vA0[i] = voffA[i]; vA1[i] = voffA[i]; vN0[i] = voffA[i]; vN1[i] = voffA[i]; }
#define PG8_GATHER(dst0, dst1, pm_) do { if constexpr (AGATHER) { _Pragma("unroll") for (int _i = 0; _i < 2; ++_i) { int R_, C_; stage_rc(tid * 16 + _i * 8192, R_, C_); \
        dst0[_i] = (g.rows[(size_t)(pm_) * BM + R_] * (unsigned)g.lda + (unsigned)C_) * 2u; dst1[_i] = (g.rows[(size_t)(pm_) * BM + HALF + R_] * (unsigned)g.lda + (unsigned)C_) * 2u; } } } while (0)
    const size_t kstepB = (size_t)(BK * 2), kstepA = ATILED ? (size_t)32768 : kstepB;
    const size_t hstepA = AGATHER ? (size_t)0 : (size_t)HALF * (ATILED ? 64 : g.lda) * 2, hstepB = (size_t)HALF * g.ldb * 2;
    const size_t tstepA = AGATHER ? (size_t)0 : ATILED ? (size_t)(K / BK) * 32768 : 2 * hstepA, tstepB = 2 * hstepB;
    const unsigned ldsw = (unsigned)wid * 1024u;
    const int aoff = lds_byte(wr * 64 + fr, fq * 8), boff = lds_byte(wc * 32 + fr, fq * 8);
#define PG8_SA(b, h) (((b) * 2 + (h)) * HTB)
#define PG8_SB(b, h) ((4 + (b) * 2 + (h)) * HTB)
#define PG8_STAGE(bufoff, gbase, voff) do { _Pragma("unroll") for (int _i = 0; _i < 2; ++_i) \
        __builtin_amdgcn_global_load_lds((const unsigned*)((const char*)(gbase) + (voff)[_i]), (PG8_LAS unsigned*)(lds + (bufoff) + ldsw + _i * 8192), 16, 0, 0); } while (0)
#define PG8_STAGE_A(bufoff, gbase, h, nx) do { _Pragma("unroll") for (int _i = 0; _i < 2; ++_i) \
        __builtin_amdgcn_global_load_lds((const unsigned*)((const char*)(gbase) + ((nx) ? ((h) ? vN1[_i] : vN0[_i]) : ((h) ? vA1[_i] : vA0[_i]))), (PG8_LAS unsigned*)(lds + (bufoff) + ldsw + _i * 8192), 16, 0, 0); } while (0)
#define PG8_LDA(dst, b, h) do { _Pragma("unroll") for (int m = 0; m < 4; ++m) _Pragma("unroll") for (int k = 0; k < 2; ++k) dst[m][k] = *(const PG8_LAS bf16x8*)(lds + PG8_SA(b, h) + aoff + m * 2048 + k * 1024); } while (0)
#define PG8_LDB(dst, b, h) do { _Pragma("unroll") for (int n = 0; n < 2; ++n) _Pragma("unroll") for (int k = 0; k < 2; ++k) dst[n][k] = *(const PG8_LAS bf16x8*)(lds + PG8_SB(b, h) + boff + n * 2048 + k * 1024); } while (0)
#define PG8_MMA(ai, bj, At, Bt) do { __builtin_amdgcn_s_setprio(1); _Pragma("unroll") for (int m = 0; m < 4; ++m) _Pragma("unroll") for (int n = 0; n < 2; ++n) _Pragma("unroll") for (int k = 0; k < 2; ++k) \
        acc[ai][bj][m][n] = __builtin_amdgcn_mfma_f32_16x16x32_bf16(Bt[n][k], At[m][k], acc[ai][bj][m][n], 0, 0, 0); __builtin_amdgcn_s_setprio(0); } while (0)
#define PG8_WAIT_V(n) asm volatile("s_waitcnt vmcnt(" #n ")" ::: "memory")
#define PG8_WAIT_L(n) asm volatile("s_waitcnt lgkmcnt(" #n ")" ::: "memory")
#define PG8_BAR __builtin_amdgcn_s_barrier()
#define PG8_SCHED __builtin_amdgcn_sched_barrier(0)
    Unit cur, nxt; int ui = 0;
    if (!S.next(0, cur)) return;
    f32x4 acc[2][2][4][2];
#pragma unroll
    for (int a = 0; a < 2; ++a)
#pragma unroll
        for (int b = 0; b < 2; ++b)
#pragma unroll
            for (int m = 0; m < 4; ++m)
#pragma unroll
                for (int n = 0; n < 2; ++n) acc[a][b][m][n] = (f32x4){0.f, 0.f, 0.f, 0.f};
    bf16x8 At[4][2], B0[2][2], B1[2][2];
    const char* cA = (const char*)g.A + (size_t)cur.pm * tstepA + (size_t)cur.pn * g.a_pn_bytes; const char* cB = (const char*)g.Bt + (size_t)cur.pn * tstepB + (size_t)cur.e * g.b_e_bytes;
    PG8_GATHER(vA0, vA1, cur.pm);
    S.a_ready(cur);
    if constexpr (SP2) {
        PG8_STAGE(PG8_SB(0, 0), cB, voffB); PG8_STAGE(PG8_SB(0, 1), cB + hstepB, voffB); PG8_STAGE_A(PG8_SA(0, 0), cA, 0, false); PG8_STAGE_A(PG8_SA(0, 1), cA + hstepA, 1, false);
        if (wr == 1) PG8_BAR;
        PG8_WAIT_V(2); PG8_BAR;
        PG8_STAGE(PG8_SB(1, 0), cB + kstepB, voffB); PG8_STAGE_A(PG8_SA(1, 0), cA + kstepA, 0, false); PG8_STAGE(PG8_SB(1, 1), cB + hstepB + kstepB, voffB);
        PG8_WAIT_V(6); PG8_BAR;
    } else {
        PG8_STAGE(PG8_SB(0, 0), cB, voffB); PG8_STAGE_A(PG8_SA(0, 0), cA, 0, false); PG8_STAGE(PG8_SB(0, 1), cB + hstepB, voffB); PG8_STAGE_A(PG8_SA(0, 1), cA + hstepA, 1, false);
        if (wr == 1) PG8_BAR;
        PG8_WAIT_V(4); PG8_BAR;
        PG8_STAGE(PG8_SB(1, 0), cB + kstepB, voffB); PG8_STAGE_A(PG8_SA(1, 0), cA + kstepA, 0, false); PG8_STAGE(PG8_SB(1, 1), cB + hstepB + kstepB, voffB);
        PG8_WAIT_V(6); PG8_BAR;
    }
    for (;;) {
        const bool has_next = S.next(ui + 1, nxt);
        if (has_next) PG8_GATHER(vN0, vN1, nxt.pm); else { _Pragma("unroll") for (int i = 0; i < 2; ++i) { vN0[i] = vA0[i]; vN1[i] = vA1[i]; } }
        const char* nA = has_next ? (const char*)g.A + (size_t)nxt.pm * tstepA + (size_t)nxt.pn * g.a_pn_bytes : cA; const char* nB = has_next ? (const char*)g.Bt + (size_t)nxt.pn * tstepB + (size_t)nxt.e * g.b_e_bytes : cB;
#pragma unroll 1
        for (int t = 0; t < nt; t += 2) {
            const bool last = (t == nt - 2);
            const char* a1 = cA + (size_t)(t + 1) * kstepA;
            const char* a2 = last ? nA : cA + (size_t)(t + 2) * kstepA; const char* b2 = last ? nB : cB + (size_t)(t + 2) * kstepB;
            const char* a3 = a2 + kstepA; const char* b3 = b2 + kstepB;
            if (last && has_next) S.a_ready(nxt);
            if constexpr (SP2) {
            PG8_LDB(B0, 0, 0); PG8_LDB(B1, 0, 1); PG8_SCHED; PG8_LDA(At, 0, 0); PG8_STAGE_A(PG8_SA(1, 1), a1 + hstepA, 1, false);
            PG8_WAIT_V(8); PG8_WAIT_L(0); PG8_BAR; PG8_MMA(0, 0, At, B0); PG8_MMA(0, 1, At, B1); PG8_BAR; PG8_SCHED;
            PG8_LDA(At, 0, 1); PG8_STAGE(PG8_SB(0, 0), b2, voffB); PG8_STAGE(PG8_SB(0, 1), b2 + hstepB, voffB); PG8_STAGE_A(PG8_SA(0, 0), a2, 0, last);
            PG8_WAIT_V(8); PG8_WAIT_L(0); PG8_BAR; PG8_MMA(1, 0, At, B0); PG8_MMA(1, 1, At, B1); PG8_BAR; PG8_SCHED;
            PG8_LDB(B0, 1, 0); PG8_LDB(B1, 1, 1); PG8_SCHED; PG8_LDA(At, 1, 0); PG8_STAGE_A(PG8_SA(0, 1), a2 + hstepA, 1, last);
            PG8_WAIT_V(8); PG8_WAIT_L(0); PG8_BAR; PG8_MMA(0, 0, At, B0); PG8_MMA(0, 1, At, B1); PG8_BAR; PG8_SCHED;
            PG8_LDA(At, 1, 1); PG8_STAGE(PG8_SB(1, 0), b3, voffB); PG8_STAGE(PG8_SB(1, 1), b3 + hstepB, voffB); PG8_STAGE_A(PG8_SA(1, 0), a3, 0, last);
            PG8_WAIT_V(8); PG8_WAIT_L(0); PG8_BAR; PG8_MMA(1, 0, At, B0); PG8_MMA(1, 1, At, B1); PG8_BAR; PG8_SCHED;
            } else {
            PG8_LDB(B0, 0, 0); PG8_SCHED; PG8_LDA(At, 0, 0); PG8_STAGE_A(PG8_SA(1, 1), a1 + hstepA, 1, false);
            PG8_WAIT_L(8); PG8_BAR; PG8_WAIT_L(0); PG8_MMA(0, 0, At, B0); PG8_BAR; PG8_SCHED;
            PG8_LDB(B1, 0, 1); PG8_STAGE(PG8_SB(0, 0), b2, voffB);
            PG8_BAR; PG8_WAIT_L(0); PG8_MMA(0, 1, At, B1); PG8_BAR;
            PG8_LDA(At, 0, 1); PG8_STAGE_A(PG8_SA(0, 0), a2, 0, last);
            PG8_BAR; PG8_WAIT_L(0); PG8_MMA(1, 0, At, B0); PG8_BAR; PG8_SCHED;
            PG8_STAGE(PG8_SB(0, 1), b2 + hstepB, voffB);
            PG8_WAIT_V(6); PG8_BAR; PG8_MMA(1, 1, At, B1); PG8_BAR;
            PG8_LDB(B0, 1, 0); PG8_SCHED; PG8_LDA(At, 1, 0); PG8_STAGE_A(PG8_SA(0, 1), a2 + hstepA, 1, last);
            PG8_WAIT_L(8); PG8_BAR; PG8_WAIT_L(0); PG8_MMA(0, 0, At, B0); PG8_BAR; PG8_SCHED;
            PG8_LDB(B1, 1, 1); PG8_STAGE(PG8_SB(1, 0), b3, voffB);
            PG8_BAR; PG8_WAIT_L(0); PG8_MMA(0, 1, At, B1); PG8_BAR;
            PG8_LDA(At, 1, 1); PG8_STAGE_A(PG8_SA(1, 0), a3, 0, last);
            PG8_BAR; PG8_WAIT_L(0); PG8_MMA(1, 0, At, B0); PG8_BAR; PG8_SCHED;
            PG8_STAGE(PG8_SB(1, 1), b3 + hstepB, voffB);
            PG8_WAIT_V(6); PG8_BAR; PG8_MMA(1, 1, At, B1); PG8_BAR;
            }
        }
        if constexpr (ALIGN_EPI) { if (wr == 0) PG8_BAR; }
        if constexpr (!Epi::AFTER_DRAIN) { E(acc, cur, wr, wc, fr, fq); S.done(cur); }
        if (!has_next) break;
#pragma unroll
        for (int a = 0; a < 2; ++a)
#pragma unroll
            for (int b = 0; b < 2; ++b)
#pragma unroll
                for (int m = 0; m < 4; ++m)
#pragma unroll
                    for (int n = 0; n < 2; ++n) acc[a][b][m][n] = (f32x4){0.f, 0.f, 0.f, 0.f};
        cur = nxt; cA = nA; cB = nB; ++ui;
#pragma unroll
        for (int i = 0; i < 2; ++i) { vA0[i] = vN0[i]; vA1[i] = vN1[i]; }
        if constexpr (ALIGN_EPI) { if (wr == 1) PG8_BAR; }
    }
    PG8_WAIT_V(0);
    if constexpr (!ALIGN_EPI) { if (wr == 0) PG8_BAR; }
    PG8_BAR;
    if constexpr (Epi::AFTER_DRAIN) { E.fused(acc, cur, wr, wc, fr, fq, lds, wid, lane); S.done(cur); }
#undef PG8_SA
#undef PG8_SB
#undef PG8_STAGE
#undef PG8_STAGE_A
#undef PG8_GATHER
#undef PG8_LDA
#undef PG8_LDB
#undef PG8_MMA
#undef PG8_WAIT_V
#undef PG8_WAIT_L
#undef PG8_BAR
#undef PG8_SCHED
}
}
#include <hip/hip_bf16.h>
#include <cmath>
namespace attn_body {
using bf16=__hip_bfloat16;
using bf16x8=__attribute__((ext_vector_type(8)))short;
using s16x4=__attribute__((ext_vector_type(4)))short;
using f32x16=__attribute__((ext_vector_type(16)))float;
using u32x4=__attribute__((ext_vector_type(4)))unsigned;
constexpr int D=64,DM=2304,SKV=8448,SCTX=256;
constexpr int NW=8,QBLK=32,QB=QBLK*NW,KVBLK=64,NQB=32;
constexpr int ATTN_PITCH=DM, ATTN_UNIT_ROWS=QB;
__device__ __forceinline__ int crow(int r,int hi){return (r&3)+8*(r>>2)+4*hi;}
#define SBAR() __builtin_amdgcn_sched_barrier(0)
__device__ __forceinline__ void cmask(f32x16&p0,f32x16&p1,int jb,int qrel,int hi){
  const float NEG=-INFINITY; int kb=64*jb+4*hi;
  #pragma unroll
  for(int r=0;r<16;++r){int kv=kb+(r&3)+8*(r>>2); if(kv>qrel)p0[r]=NEG; if(kv+32>qrel)p1[r]=NEG;}
}

constexpr int NSLOT=3, SLOTB=8192;
constexpr int LDS_K=0, LDS_V=NSLOT*SLOTB, LDS_WS=2*NSLOT*SLOTB, LDS_OST=LDS_WS+NW*64*4, LDS_BYTES=LDS_OST+NW*4096;
constexpr float C2=0.125f*1.4426950408889634f;
__device__ __forceinline__ void glds16(const void*gsrc,unsigned lds_dst){unsigned keep;
  asm volatile("s_mov_b32 %0, m0\n\ts_mov_b32 m0, %2\n\ts_nop 0\n\tglobal_load_lds_dwordx4 %1, off\n\ts_mov_b32 m0, %0":"=&s"(keep):"v"(gsrc),"s"(lds_dst):"memory");}
__device__ __forceinline__ float max3f(float a,float b,float c){float r;asm("v_max3_f32 %0, %1, %2, %3":"=v"(r):"v"(a),"v"(b),"v"(c));return r;}
__device__ __forceinline__ float max2f(float a,float b){float r;asm("v_max_f32_e32 %0, %1, %2":"=v"(r):"v"(a),"v"(b));return r;}
__device__ __forceinline__ float fadd_s(float a,float b){float r;asm("v_add_f32_e32 %0, %1, %2":"=v"(r):"v"(a),"v"(b));return r;}
__device__ __forceinline__ float fsub_s(float a,float b){float r;asm("v_sub_f32_e32 %0, %1, %2":"=v"(r):"v"(a),"v"(b));return r;}
typedef float f32x2_t __attribute__((ext_vector_type(2))); typedef __bf16 bf16x2_t __attribute__((ext_vector_type(2)));
__device__ __forceinline__ unsigned cvtpk_s(float lo,float hi){f32x2_t v={lo,hi};bf16x2_t b=__builtin_convertvector(v,bf16x2_t);return __builtin_bit_cast(unsigned,b);}
#define WAIT_BAR(N) asm volatile("s_waitcnt vmcnt(" #N ") lgkmcnt(0)\n\ts_barrier":::"memory")

__device__ __forceinline__ void qkt(f32x16&p0,f32x16&p1,const char*Kslot,const bf16x8*qr,const f32x16&negm,int r32,int hi){
  const char*kb=Kslot+hi*1024+r32*16;
  #pragma unroll
  for(int d0=0;d0<4;++d0){
    const bf16x8 b0=*reinterpret_cast<const bf16x8*>(kb+d0*2048);
    const bf16x8 b1=*reinterpret_cast<const bf16x8*>(kb+d0*2048+512);
    if(d0==0){p0=__builtin_amdgcn_mfma_f32_32x32x16_bf16(b0,qr[0],negm,0,0,0);p1=__builtin_amdgcn_mfma_f32_32x32x16_bf16(b1,qr[0],negm,0,0,0);}
    else{p0=__builtin_amdgcn_mfma_f32_32x32x16_bf16(b0,qr[d0],p0,0,0,0);p1=__builtin_amdgcn_mfma_f32_32x32x16_bf16(b1,qr[d0],p1,0,0,0);}}
}
typedef __attribute__((address_space(3))) const char* lds_cptr;
typedef short v4i16_t __attribute__((ext_vector_type(4)));
__device__ __forceinline__ void kload8(bf16x8*kf,lds_cptr kp){
  kf[0]=*(const __attribute__((address_space(3))) bf16x8*)(kp);      kf[1]=*(const __attribute__((address_space(3))) bf16x8*)(kp+512);
  kf[2]=*(const __attribute__((address_space(3))) bf16x8*)(kp+2048); kf[3]=*(const __attribute__((address_space(3))) bf16x8*)(kp+2560);
  kf[4]=*(const __attribute__((address_space(3))) bf16x8*)(kp+4096); kf[5]=*(const __attribute__((address_space(3))) bf16x8*)(kp+4608);
  kf[6]=*(const __attribute__((address_space(3))) bf16x8*)(kp+6144); kf[7]=*(const __attribute__((address_space(3))) bf16x8*)(kp+6656);
}
__device__ __forceinline__ void kload2(bf16x8*kf,lds_cptr kp,int j){ kf[2*j]=*(const __attribute__((address_space(3))) bf16x8*)(kp+j*2048); kf[2*j+1]=*(const __attribute__((address_space(3))) bf16x8*)(kp+j*2048+512); }
__device__ __forceinline__ s16x4 vtr(lds_cptr p){ return __builtin_bit_cast(s16x4,__builtin_amdgcn_ds_read_tr16_b64_v4i16((__attribute__((address_space(3))) v4i16_t*)p)); }
__device__ __forceinline__ float rowmax(const f32x16&p0,const f32x16&p1){
  float a=max3f(p0[0],p0[1],p1[0]),b=max3f(p0[2],p0[3],p1[1]);a=max3f(a,p1[2],p1[3]);
  #pragma unroll
  for(int r=4;r<16;r+=4){a=max3f(a,p0[r],p0[r+1]);b=max3f(b,p0[r+2],p0[r+3]);a=max3f(a,p1[r],p1[r+1]);b=max3f(b,p1[r+2],p1[r+3]);}
  const float m=max2f(a,b);
  auto rr=__builtin_amdgcn_permlane32_swap(__float_as_uint(m),__float_as_uint(m),false,false);
  return max2f(__uint_as_float(rr[0]),__uint_as_float(rr[1]));
}
__device__ __forceinline__ void pv(f32x16*o,int vb,bf16x8 pa0,bf16x8 pa1,bf16x8 pa2,bf16x8 pa3){
  #pragma unroll
  for(int d0=0;d0<2;++d0){s16x4 lo[4],hi[4];
    #pragma unroll
    for(int ks=0;ks<4;++ks){
      asm volatile("ds_read_b64_tr_b16 %0,%1 offset:%c2":"=&v"(lo[ks]):"v"(vb),"i"(d0*4096+ks*1024):"memory");
      asm volatile("ds_read_b64_tr_b16 %0,%1 offset:%c2":"=&v"(hi[ks]):"v"(vb),"i"(d0*4096+ks*1024+512):"memory");}
    asm volatile("s_waitcnt lgkmcnt(0)":::"memory");SBAR();
    #define PK(k) (bf16x8){lo[k][0],lo[k][1],lo[k][2],lo[k][3],hi[k][0],hi[k][1],hi[k][2],hi[k][3]}
    o[d0]=__builtin_amdgcn_mfma_f32_32x32x16_bf16(pa0,PK(0),o[d0],0,0,0);
    o[d0]=__builtin_amdgcn_mfma_f32_32x32x16_bf16(pa1,PK(1),o[d0],0,0,0);
    o[d0]=__builtin_amdgcn_mfma_f32_32x32x16_bf16(pa2,PK(2),o[d0],0,0,0);
    o[d0]=__builtin_amdgcn_mfma_f32_32x32x16_bf16(pa3,PK(3),o[d0],0,0,0);
    #undef PK
  }
}

#ifndef ATTN_STORE16
#define ATTN_STORE16(p,v) (*(u32x4*)(p)=(v))
#endif
template<int THRL,bool FIXREF,int NTP> __device__ __forceinline__ void attn_unit(int b,int h,int q0,const bf16*Q,const bf16*__restrict__ K,const bf16*__restrict__ V,bf16*O,char*shm,float smax,const float*qg,const float*ropeT){
  int tid_=threadIdx.x; asm volatile("":"+v"(tid_)); const int tid=tid_,lane=tid&63,r32=lane&31,hi=lane>>5; const int wid=__builtin_amdgcn_readfirstlane(tid>>6);
  const long rowbase=(long)b*SKV; const int kvh=h>>2;
  const bf16*Qw=Q+(rowbase+q0+wid*QBLK)*DM+h*D;
  const bf16*Kh=K+rowbase*DM+kvh*D,*Vh=V+rowbase*DM+kvh*D;
  const unsigned lds0=(unsigned)(uintptr_t)shm;
  float*wsf=(float*)(shm+LDS_WS)+wid*64;
  const bf16*ksrc=Kh+(long)lane*DM+wid*8;
  const bf16*vsrc=Vh+(long)(16*(wid&3)+(lane>>2))*DM+(wid>>2)*32+(lane&3)*8;
  const unsigned kdst=lds0+LDS_K+wid*1024, vdst=lds0+LDS_V+wid*1024;
  #define DMA_K(t,slot) glds16(ksrc+(long)(t)*KVBLK*DM,(unsigned)__builtin_amdgcn_readfirstlane(kdst+(slot)))
  #define DMA_V(t,slot) glds16(vsrc+(long)(t)*KVBLK*DM,(unsigned)__builtin_amdgcn_readfirstlane(vdst+(slot)))
  const int vb0=(int)(lds0+LDS_V)+((lane>>4)&1)*32+(lane&3)*8+(4*hi+((lane&15)>>2))*64;
  const char*Kbase=shm+LDS_K; bf16x8 kf[8];
  const lds_cptr shm3=(lds_cptr)shm; const lds_cptr kp0=shm3+LDS_K+hi*1024+r32*16; const lds_cptr vp0=shm3+LDS_V+((lane>>4)&1)*32+(lane&3)*8+(4*hi+((lane&15)>>2))*64;
  constexpr int NT=NTP;
  DMA_K(0,0);DMA_V(0,0);DMA_K(1,SLOTB);
  bf16x8 qr[4];
  #pragma unroll
  for(int d0=0;d0<4;++d0)qr[d0]=*reinterpret_cast<const bf16x8*>(&Qw[(long)r32*DM+d0*16+hi*8]);
  float mhat=0.f,l_reg=0.f;f32x16 o[2];o[0]=f32x16{};o[1]=f32x16{};f32x16 negm=f32x16{}; if(FIXREF){ _Pragma("unroll") for(int r=0;r<16;++r)negm[r]=-smax; } asm volatile("":"+v"(negm));
  const int qrel=wid*QBLK+r32;
  #define CMASK(P0,P1,t) do{}while(0)
  bool resc=false;
  #define START(P0,P1) do{ if constexpr(!FIXREF){ const float rm=rowmax(P0,P1); resc=false; \
    { const float dl=rm; mhat=fadd_s(mhat,dl); \
      _Pragma("unroll") for(int r=0;r<16;++r){P0[r]=fsub_s(P0[r],dl);P1[r]=fsub_s(P1[r],dl);} \
      _Pragma("unroll") for(int r=0;r<16;++r)negm[r]=-mhat; asm volatile("":"+v"(negm)); } } \
    _Pragma("unroll") for(int r=0;r<16;++r)P0[r]=__builtin_amdgcn_exp2f(P0[r]); }while(0)
  #define RESC() do{ if constexpr(!FIXREF) if(resc){ asm volatile("s_waitcnt lgkmcnt(0)":::"memory"); \
      _Pragma("unroll") for(int d_=0;d_<2;++d_) _Pragma("unroll") for(int r=0;r<16;++r)o[d_][r]*=wsf[crow(r,hi)]; } }while(0)
  f32x16 pA0,pA1,pB0,pB1;
  int sl_prev=0,sl_cur=0,sl_next=SLOTB;
  #define ROT() do{sl_prev=sl_cur;sl_cur=sl_next;sl_next=(sl_next==(NSLOT-1)*SLOTB)?0:sl_next+SLOTB;}while(0)
  DMA_K(2,2*SLOTB);
  WAIT_BAR(3);
  qkt(pA0,pA1,Kbase,qr,negm,r32,hi);asm volatile("s_nop 15\n\ts_nop 7":"+v"(pA0),"+v"(pA1));CMASK(pA0,pA1,0);
  START(pA0,pA1);
  _Pragma("unroll") for(int r=0;r<16;++r)pA1[r]=__builtin_amdgcn_exp2f(pA1[r]);
  WAIT_BAR(0);
  DMA_K(3,0);DMA_V(1,SLOTB);
  ROT();
  kload8(kf,kp0+sl_cur);
  WAIT_BAR(2);
  s16x4 vlo[8],vhi[8]; u32x4 pw0,pw1,pw2,pw3;
  #define PKW(P,B) cvtpk_s(P[B],P[B+1])
  #define PAF(k) __builtin_bit_cast(bf16x8,pw##k)
  #define VFR(i) (bf16x8){vlo[i][0],vlo[i][1],vlo[i][2],vlo[i][3],vhi[i][0],vhi[i][1],vhi[i][2],vhi[i][3]}
  #define PIN(x) asm volatile("":"+v"(x))
  #define MX3(a,b,c) __builtin_fmaxf(__builtin_fmaxf((a),(b)),(c))
  #define GAPA(MF,A0,A1,A2,A3,W0,W1,PW) do{ MF; sacc+=A0; sacc+=A1; sacc+=A2; sacc+=A3; PIN(sacc); W0; W1; PIN(PW); SBAR(); }while(0)
  #define EX(v) __builtin_amdgcn_exp2f(v)
  #define GAPB(MF,X,B) do{ MF; X[B]=EX(X[B]); X[B+1]=EX(X[B+1]); X[B+2]=EX(X[B+2]); X[B+3]=EX(X[B+3]); PIN(X); SBAR(); }while(0)
  #define VRD(i) do{ vlo[i]=vtr(vp_+(((i)>>2)*4096+((i)&3)*1024)); vhi[i]=vtr(vp_+(((i)>>2)*4096+((i)&3)*1024+512)); }while(0)
  #define KRD(G,j) do{ if(G){ kload2(kf,kp0+sl_next,j); SBAR(); } }while(0)
  #define STEP(C0,C1,P0,P1,t,GK,GV,GL) do{ SBAR(); \
    const lds_cptr vp_=vp0+sl_prev; \
    VRD(0); SBAR(); float sacc=(P0[0]+P0[1]); \
    GAPA(C0=__builtin_amdgcn_mfma_f32_32x32x16_bf16(kf[0],qr[0],negm,0,0,0), P0[2],P0[3],P0[4],P0[5],     pw0[0]=PKW(P0,0), pw0[1]=PKW(P0,2), pw0); \
    VRD(4); SBAR(); GAPA(C1=__builtin_amdgcn_mfma_f32_32x32x16_bf16(kf[1],qr[0],negm,0,0,0), P0[6],P0[7],P0[8],P0[9],     pw0[2]=PKW(P0,4), pw0[3]=PKW(P0,6), pw0); \
    VRD(1); SBAR(); GAPA(C0=__builtin_amdgcn_mfma_f32_32x32x16_bf16(kf[2],qr[1],C0,0,0,0),   P0[10],P0[11],P0[12],P0[13], pw1[0]=PKW(P0,8), pw1[1]=PKW(P0,10), pw1); \
    VRD(5); SBAR(); GAPA(C1=__builtin_amdgcn_mfma_f32_32x32x16_bf16(kf[3],qr[1],C1,0,0,0),   P0[14],P0[15],P1[0],P1[1],   pw1[2]=PKW(P0,12),pw1[3]=PKW(P0,14), pw1); \
    VRD(2); SBAR(); GAPA(C0=__builtin_amdgcn_mfma_f32_32x32x16_bf16(kf[4],qr[2],C0,0,0,0),   P1[2],P1[3],P1[4],P1[5],     pw2[0]=PKW(P1,0), pw2[1]=PKW(P1,2), pw2); \
    VRD(6); SBAR(); GAPA(C1=__builtin_amdgcn_mfma_f32_32x32x16_bf16(kf[5],qr[2],C1,0,0,0),   P1[6],P1[7],P1[8],P1[9],     pw2[2]=PKW(P1,4), pw2[3]=PKW(P1,6), pw2); \
    VRD(3); SBAR(); GAPA(C0=__builtin_amdgcn_mfma_f32_32x32x16_bf16(kf[6],qr[3],C0,0,0,0),   P1[10],P1[11],P1[12],P1[13], pw3[0]=PKW(P1,8), pw3[1]=PKW(P1,10), pw3); \
    VRD(7); SBAR(); GAPA(C1=__builtin_amdgcn_mfma_f32_32x32x16_bf16(kf[7],qr[3],C1,0,0,0),   P1[14],P1[15],0.f,0.f,       pw3[2]=PKW(P1,12),pw3[3]=PKW(P1,14), pw3); \
    l_reg+=sacc; \
    if(GK){DMA_K((t)+3,sl_cur);} if(GV){DMA_V((t)+1,sl_next);} \
    CMASK(C0,C1,t); \
    if constexpr(!FIXREF){ float a=MX3(C0[0],C0[1],C1[0]),b=MX3(C0[2],C0[3],C1[1]); a=MX3(a,C1[2],C1[3]); \
      _Pragma("unroll") for(int r=4;r<16;r+=4){a=MX3(a,C0[r],C0[r+1]);b=MX3(b,C0[r+2],C0[r+3]);a=MX3(a,C1[r],C1[r+1]);b=MX3(b,C1[r+2],C1[r+3]);} \
      float rm=__builtin_fmaxf(a,b); { auto rr=__builtin_amdgcn_permlane32_swap(__float_as_uint(rm),__float_as_uint(rm),false,false); rm=__builtin_fmaxf(__uint_as_float(rr[0]),__uint_as_float(rr[1])); } \
      resc=false; \
      if(__builtin_expect(__any(rm>(float)THRL),0)){ const float dl=__builtin_fmaxf(rm,0.f); mhat+=dl; \
        _Pragma("unroll") for(int r=0;r<16;++r){C0[r]-=dl;C1[r]-=dl;} \
        _Pragma("unroll") for(int r=0;r<16;++r)negm[r]=-mhat; asm volatile("":"+v"(negm)); \
        const float f=__builtin_amdgcn_exp2f(-dl); l_reg*=f; if(hi==0)wsf[r32]=f; resc=true; } } \
    SBAR(); \
    GAPB(o[0]=__builtin_amdgcn_mfma_f32_32x32x16_bf16(PAF(0),VFR(0),o[0],0,0,0), C0,0); \
    GAPB(o[1]=__builtin_amdgcn_mfma_f32_32x32x16_bf16(PAF(0),VFR(4),o[1],0,0,0), C0,4); \
    KRD(GL,0); GAPB(o[0]=__builtin_amdgcn_mfma_f32_32x32x16_bf16(PAF(1),VFR(1),o[0],0,0,0), C0,8); \
    KRD(GL,1); GAPB(o[1]=__builtin_amdgcn_mfma_f32_32x32x16_bf16(PAF(1),VFR(5),o[1],0,0,0), C0,12); \
    KRD(GL,2); GAPB(o[0]=__builtin_amdgcn_mfma_f32_32x32x16_bf16(PAF(2),VFR(2),o[0],0,0,0), C1,0); \
    KRD(GL,3); GAPB(o[1]=__builtin_amdgcn_mfma_f32_32x32x16_bf16(PAF(2),VFR(6),o[1],0,0,0), C1,4); \
    GAPB(o[0]=__builtin_amdgcn_mfma_f32_32x32x16_bf16(PAF(3),VFR(3),o[0],0,0,0), C1,8); \
    GAPB(o[1]=__builtin_amdgcn_mfma_f32_32x32x16_bf16(PAF(3),VFR(7),o[1],0,0,0), C1,12); \
    }while(0)
  int t=1;
  for(;t+5<NT;t+=2){
    STEP(pB0,pB1,pA0,pA1,t,true,true,true);     WAIT_BAR(2); RESC(); ROT();
    STEP(pA0,pA1,pB0,pB1,t+1,true,true,true);   WAIT_BAR(2); RESC(); ROT();
  }
  #define ENDW(tt) do{ if((tt)+3<NT){WAIT_BAR(2);} else if((tt)+2<NT){WAIT_BAR(1);} else {WAIT_BAR(0);} }while(0)
  for(;t+1<NT;t+=2){
    STEP(pB0,pB1,pA0,pA1,t,(t+3<NT),(t+1<NT),(t+1<NT));       ENDW(t);   RESC(); ROT();
    STEP(pA0,pA1,pB0,pB1,t+1,(t+4<NT),(t+2<NT),(t+2<NT));     ENDW(t+1); RESC(); ROT();
  }
  STEP(pB0,pB1,pA0,pA1,NT-1,false,false,false); RESC();
  { float sacc=pB0[0]+pB0[1]; _Pragma("unroll") for(int r=2;r<16;++r)sacc+=pB0[r]; _Pragma("unroll") for(int r=0;r<16;++r)sacc+=pB1[r]; l_reg+=sacc;
    pw0=(u32x4){PKW(pB0,0),PKW(pB0,2),PKW(pB0,4),PKW(pB0,6)};pw1=(u32x4){PKW(pB0,8),PKW(pB0,10),PKW(pB0,12),PKW(pB0,14)};pw2=(u32x4){PKW(pB1,0),PKW(pB1,2),PKW(pB1,4),PKW(pB1,6)};pw3=(u32x4){PKW(pB1,8),PKW(pB1,10),PKW(pB1,12),PKW(pB1,14)};
    SBAR(); pv(o,vb0+sl_cur,PAF(0),PAF(1),PAF(2),PAF(3)); }
  #undef PKW
  #undef PAF
  #undef VFR
  #undef PIN
  #undef MX3
  #undef GAPA
  #undef GAPB
  #undef EX
  #undef VRD
  #undef KRD
  #undef STEP
  #undef ENDW
  {auto rr=__builtin_amdgcn_permlane32_swap(__float_as_uint(l_reg),__float_as_uint(l_reg),false,false);l_reg=__uint_as_float(rr[0])+__uint_as_float(rr[1]);}
  if(hi==0)wsf[32+r32]=l_reg;asm volatile("s_waitcnt lgkmcnt(0)":::"memory");
  float rli[16];
  #pragma unroll
  for(int r=0;r<16;++r)rli[r]=__builtin_amdgcn_rcpf(wsf[32+crow(r,hi)]);
  bf16*Ow=O+(rowbase+q0+wid*QBLK)*DM+h*D;
  { bf16*stg=(bf16*)(shm+LDS_OST)+wid*2048;
    #pragma unroll
    for(int r=0;r<16;++r){const int orow=crow(r,hi);
      #pragma unroll
      for(int d0=0;d0<2;++d0)stg[orow*64+d0*32+r32]=__float2bfloat16(o[d0][r]*rli[r]);}
    asm volatile("s_waitcnt lgkmcnt(0)":::"memory");
    #pragma unroll
    for(int i=0;i<4;++i){const int row=i*8+(lane>>3),ch=lane&7; const u32x4 v=*(const u32x4*)(stg+row*64+ch*8); ATTN_STORE16(Ow+(long)row*DM+ch*8,v);} }
  asm volatile("s_waitcnt lgkmcnt(0)\n\ts_barrier":::"memory");
  #undef DMA_K
  #undef DMA_V
  #undef CMASK
  #undef START
  #undef RESC
  #undef ROT
}
typedef float f32x4_t __attribute__((ext_vector_type(4)));
#define MFMA16(a,b,c) __builtin_amdgcn_mfma_f32_16x16x32_bf16(a,b,c,0,0,0)
__device__ __forceinline__ bf16x8 vfrag(const s16x4 lo,const s16x4 hi){ return (bf16x8){lo[0],lo[1],lo[2],lo[3],hi[0],hi[1],hi[2],hi[3]}; }
template<int NTP> __device__ __forceinline__ void attn_unit16(int b,int h,int q0,const bf16*Q,const bf16*__restrict__ K,const bf16*__restrict__ V,bf16*O,char*shm,float smax){
  int tid_=threadIdx.x; asm volatile("":"+v"(tid_)); const int tid=tid_,lane=tid&63,l15=lane&15,g=lane>>4; const int wid=__builtin_amdgcn_readfirstlane(tid>>6);
  const long rowbase=(long)b*SKV; const int kvh=h>>2;
  const bf16*Qw=Q+(rowbase+q0+wid*QBLK)*DM+h*D;
  const bf16*Kh=K+rowbase*DM+kvh*D,*Vh=V+rowbase*DM+kvh*D;
  const unsigned lds0=(unsigned)(uintptr_t)shm;
  float*wsf=(float*)(shm+LDS_WS)+wid*64;
  const bf16*ksrc=Kh+(long)lane*DM+wid*8;
  const bf16*vsrc=Vh+(long)(16*(wid&3)+(lane>>2))*DM+(wid>>2)*32+(lane&3)*8;
  const unsigned kdst=lds0+LDS_K+wid*1024, vdst=lds0+LDS_V+wid*1024;
  #define DMA_K(t,slot) glds16(ksrc+(long)(t)*KVBLK*DM,(unsigned)__builtin_amdgcn_readfirstlane(kdst+(slot)))
  #define DMA_V(t,slot) glds16(vsrc+(long)(t)*KVBLK*DM,(unsigned)__builtin_amdgcn_readfirstlane(vdst+(slot)))
  const int rp=8*((l15>>2)&1)+4*(l15>>3)+(l15&3);
  const lds_cptr shm3=(lds_cptr)shm; const lds_cptr kp0=shm3+LDS_K+g*1024+rp*16;
  const lds_cptr vp0=shm3+LDS_V+(8*(g&1)+4*(g>>1)+(l15>>2))*64+(l15&3)*8;
  constexpr int NT=NTP;
  DMA_K(0,0);DMA_V(0,0);DMA_K(1,SLOTB);
  bf16x8 qf[2][2];
  #pragma unroll
  for(int q2=0;q2<2;++q2)
    #pragma unroll
    for(int ds=0;ds<2;++ds)qf[q2][ds]=*reinterpret_cast<const bf16x8*>(&Qw[(long)(16*q2+l15)*DM+32*ds+8*g]);
  f32x4_t o[2][4];
  #pragma unroll
  for(int q2=0;q2<2;++q2)
    #pragma unroll
    for(int db=0;db<4;++db)o[q2][db]=f32x4_t{0.f,0.f,0.f,0.f};
  float ls0=0.f,ls1=0.f;
  f32x4_t negm=f32x4_t{-smax,-smax,-smax,-smax}; asm volatile("":"+v"(negm));
  f32x4_t sA[4][2],sB[4][2]; bf16x8 kf[4][2];
  int sl_prev=0,sl_cur=0,sl_next=SLOTB;
  #define ROT() do{sl_prev=sl_cur;sl_cur=sl_next;sl_next=(sl_next==(NSLOT-1)*SLOTB)?0:sl_next+SLOTB;}while(0)
  #define KLD(kb,ds,slot) kf[kb][ds]=*(const __attribute__((address_space(3))) bf16x8*)(kp0+(slot)+(ds)*4096+(kb)*256)
  #define PIN(x) asm volatile("":"+v"(x))
  #define EX(v) __builtin_amdgcn_exp2f(v)
  DMA_K(2,2*SLOTB);
  WAIT_BAR(3);
  #pragma unroll
  for(int kb=0;kb<4;++kb){KLD(kb,0,0);KLD(kb,1,0);}
  #pragma unroll
  for(int kb=0;kb<4;++kb)
    #pragma unroll
    for(int q2=0;q2<2;++q2){ sA[kb][q2]=MFMA16(kf[kb][0],qf[q2][0],negm); sA[kb][q2]=MFMA16(kf[kb][1],qf[q2][1],sA[kb][q2]); }
  #pragma unroll
  for(int kb=0;kb<4;++kb)
    #pragma unroll
    for(int q2=0;q2<2;++q2)
      #pragma unroll
      for(int r=0;r<4;++r)sA[kb][q2][r]=EX(sA[kb][q2][r]);
  WAIT_BAR(0);
  DMA_K(3,0);DMA_V(1,SLOTB);
  ROT();
  #pragma unroll
  for(int kb=0;kb<4;++kb){KLD(kb,0,sl_cur);KLD(kb,1,sl_cur);}
  WAIT_BAR(2);
  #define VTR(off) vtr(vp_+(off))
  #define STEP16(C,P,t,GK,GV,GL) do{ SBAR(); const lds_cptr vp_=vp0+sl_prev; s16x4 vlo[2][4],vhi[2][4]; u32x4 pw[2][2]; \
    _Pragma("unroll") for(int i_=0;i_<16;++i_){ const int s_=i_>>3,db_=(i_>>1)&3,hf_=i_&1; \
      if(hf_==0) vlo[s_][db_]=VTR(s_*2048+(db_>>1)*4096+(db_&1)*32); else vhi[s_][db_]=VTR(s_*2048+1024+(db_>>1)*4096+(db_&1)*32); SBAR(); \
      { const int ds_=i_>>3,kb_=(i_&7)>>1,q2_=i_&1; C[kb_][q2_]=MFMA16(kf[kb_][ds_],qf[q2_][ds_],ds_==0?negm:C[kb_][q2_]); } \
      { const int pb_=i_>>1,pk_=pb_>>1,pq_=pb_&1; const float a0_=P[pk_][pq_][2*hf_],a1_=P[pk_][pq_][2*hf_+1]; if(pq_==0){ls0+=a0_;ls0+=a1_;PIN(ls0);}else{ls1+=a0_;ls1+=a1_;PIN(ls1);} \
        pw[pq_][pk_>>1][(pk_&1)*2+hf_]=cvtpk_s(a0_,a1_); PIN(pw[pq_][pk_>>1]); } SBAR(); } \
    if(GK){DMA_K((t)+3,sl_cur);} if(GV){DMA_V((t)+1,sl_next);} SBAR(); \
    _Pragma("unroll") for(int i_=0;i_<16;++i_){ const int s_=i_>>3,q2_=(i_&7)>>2,db_=i_&3; \
      if((GL)&&i_>=4&&i_<12){ const int j_=i_-4; KLD(j_>>1,j_&1,sl_next); SBAR(); } \
      o[q2_][db_]=MFMA16(__builtin_bit_cast(bf16x8,pw[q2_][s_]),vfrag(vlo[s_][db_],vhi[s_][db_]),o[q2_][db_]); \
      { const int cb_=i_>>1,ck_=cb_>>1,cq_=cb_&1,hf_=i_&1; C[ck_][cq_][2*hf_]=EX(C[ck_][cq_][2*hf_]); C[ck_][cq_][2*hf_+1]=EX(C[ck_][cq_][2*hf_+1]); PIN(C[ck_][cq_]); } SBAR(); } \
    }while(0)
  int t=1;
  for(;t+5<NT;t+=2){
    STEP16(sB,sA,t,true,true,true);     WAIT_BAR(2); ROT();
    STEP16(sA,sB,t+1,true,true,true);   WAIT_BAR(2); ROT();
  }
  #define ENDW(tt) do{ if((tt)+3<NT){WAIT_BAR(2);} else if((tt)+2<NT){WAIT_BAR(1);} else {WAIT_BAR(0);} }while(0)
  for(;t+1<NT;t+=2){
    STEP16(sB,sA,t,(t+3<NT),(t+1<NT),(t+1<NT));       ENDW(t);   ROT();
    STEP16(sA,sB,t+1,(t+4<NT),(t+2<NT),(t+2<NT));     ENDW(t+1); ROT();
  }
  STEP16(sB,sA,NT-1,false,false,false);
  { const lds_cptr vp_=vp0+sl_cur; u32x4 pw[2][2];
    #pragma unroll
    for(int kb=0;kb<4;++kb)
      #pragma unroll
      for(int q2=0;q2<2;++q2){ const f32x4_t p=sB[kb][q2]; if(q2==0)ls0+=(p[0]+p[1])+(p[2]+p[3]); else ls1+=(p[0]+p[1])+(p[2]+p[3]); pw[q2][kb>>1][(kb&1)*2]=cvtpk_s(p[0],p[1]); pw[q2][kb>>1][(kb&1)*2+1]=cvtpk_s(p[2],p[3]); }
    #pragma unroll
    for(int s=0;s<2;++s)
      #pragma unroll
      for(int db=0;db<4;++db){ const s16x4 lo=VTR(s*2048+(db>>1)*4096+(db&1)*32), hi=VTR(s*2048+1024+(db>>1)*4096+(db&1)*32); const bf16x8 vf=vfrag(lo,hi);
        #pragma unroll
        for(int q2=0;q2<2;++q2)o[q2][db]=MFMA16(__builtin_bit_cast(bf16x8,pw[q2][s]),vf,o[q2][db]); } }
  ls0+=__shfl_xor(ls0,16); ls0+=__shfl_xor(ls0,32); ls1+=__shfl_xor(ls1,16); ls1+=__shfl_xor(ls1,32);
  if(g==0){wsf[l15]=ls0;wsf[16+l15]=ls1;} asm volatile("s_waitcnt lgkmcnt(0)":::"memory");
  bf16*Ow=O+(rowbase+q0+wid*QBLK)*DM+h*D;
  { bf16*stg=(bf16*)(shm+LDS_OST)+wid*2048;
    #pragma unroll
    for(int q2=0;q2<2;++q2)
      #pragma unroll
      for(int r=0;r<4;++r){ const int orow=16*q2+4*g+r; const float rl=__builtin_amdgcn_rcpf(wsf[orow]);
        #pragma unroll
        for(int db=0;db<4;++db)stg[orow*64+16*db+l15]=__float2bfloat16(o[q2][db][r]*rl); }
    asm volatile("s_waitcnt lgkmcnt(0)":::"memory");
    #pragma unroll
    for(int i=0;i<4;++i){const int row=i*8+(lane>>3),ch=lane&7; const u32x4 v=*(const u32x4*)(stg+row*64+ch*8); ATTN_STORE16(Ow+(long)row*DM+ch*8,v);} }
  asm volatile("s_waitcnt lgkmcnt(0)\n\ts_barrier":::"memory");
  #undef DMA_K
  #undef DMA_V
  #undef ROT
  #undef KLD
  #undef PIN
  #undef EX
  #undef VTR
  #undef STEP16
  #undef ENDW
}
constexpr int ATTN_LDS_BYTES=LDS_BYTES;
constexpr int N_UNITS=8*8*NQB;
template<int THRL,bool FIXREF,class Hook> __device__ __forceinline__ void attn_phase(char*lds,bf16*Z,bf16*Ob,int G,int vcu,float smax,const float*qg,const float*ropeT,const Hook&hook){
  int ui=0;
  for(int L=vcu;L<N_UNITS;L+=G){ const int pair=L>>7,rem=L&127,b=pair>>1,h=(pair&1)*4+(rem>>5),qb=rem&31;
    if constexpr(FIXREF) attn_unit16<SKV/KVBLK>(b,h,SCTX+qb*QB,Z,Z+1024,Z+1152,Ob,lds,smax); else attn_unit<THRL,false,SKV/KVBLK>(b,h,SCTX+qb*QB,Z,Z+1024,Z+1152,Ob,lds,smax,qg,ropeT);
    hook(ui); ++ui; }
  for(int L=vcu;L<64;L+=G){ const int b=L>>3,h=L&7;
    if constexpr(FIXREF) attn_unit16<SCTX/KVBLK>(b,h,0,Z,Z+1024,Z+1152,Ob,lds,smax); else attn_unit<THRL,false,SCTX/KVBLK>(b,h,0,Z,Z+1024,Z+1152,Ob,lds,smax,qg,ropeT); }
}
#undef SBAR
#undef WAIT_BAR
}
constexpr int NWAVES = 8;
#ifndef MK_PER_PHASE
#define MK_PER_PHASE 0
#endif
constexpr int NPHASE = 16;
#ifndef PROBE_DUP
#define PROBE_DUP -1
#endif
#ifndef PROBE_NOSTORE
#define PROBE_NOSTORE 0
#endif

constexpr int NB = 8, SEQ = 8192, DMODEL = 1024, CTXL = 256, SROW = SEQ + CTXL  ;
constexpr int MC = NB * SROW  , ML = NB * SEQ  ;
constexpr int ZP = 2304;
constexpr int DFF = 2816, DFE = 1408, NEXP = 8, NMODV = 6 * DMODEL;
constexpr int MS_MAX = 2 * ML + NEXP * 256;
constexpr float EPS = 1e-6f;
constexpr float QSCALE = 0.125f * 1.4426950408889634f;

constexpr size_t MiB = 1u << 20;
constexpr size_t WS_CTL = 0, CTL_ZERO_BYTES = 1 * MiB;
constexpr size_t WS_MOD = 1 * MiB;
constexpr size_t WS_ROPE = WS_MOD + 512 * 1024;
constexpr size_t WS_HIST = WS_ROPE + 64 * 1024;
constexpr size_t WS_TOKRS = WS_HIST + 128 * 1024;
constexpr size_t WS_GSC = WS_HIST + 64 * 1024;
constexpr size_t WS_TOKE = 2 * MiB, WS_TOKR = WS_TOKE + 256 * 1024, WS_TOKP = WS_TOKR + 256 * 1024, WS_TOKS = WS_TOKP + 256 * 1024;
constexpr size_t WS_TOKL = 3 * MiB + 256 * 1024;
constexpr size_t WS_SSQ = 4 * MiB;
constexpr size_t WS_WIN = 8 * MiB, WS_WOUT = 13 * MiB, WS_WGU = 15 * MiB, WS_WD = 26 * MiB, WS_WP = 32 * MiB, WS_WEGU = 33 * MiB, WS_WED = 77 * MiB;
constexpr size_t WS_A = 104 * MiB;
constexpr size_t WS_R1 = 240 * MiB;
constexpr size_t WS_R2 = 600 * MiB;
constexpr size_t WS_XR = 864 * MiB;
constexpr size_t WS_XRC = 99 * MiB;
constexpr size_t WS_A1C = 236 * MiB;
constexpr size_t WS_HC = 992 * MiB;
constexpr size_t WS_YC = 1003 * MiB;
constexpr size_t WS_END = 1011 * MiB;
static_assert(WS_WED + (size_t)NEXP * 1024 * DFE * 2 <= WS_A && WS_A + (size_t)MC * 1024 * 2 <= WS_R1 && WS_R1 + (size_t)MS_MAX * DFE * 2 <= WS_R2 && WS_R1 + (size_t)ML * DFF * 2 <= WS_R2 && WS_R2 + (size_t)MS_MAX * 1024 * 2 <= WS_XR && WS_XR + (size_t)ML * 1024 * 2 <= WS_END, "d_ws map");
constexpr int CW_TMO = 0, CW_CODE = 1;
constexpr int CW_BAR = 4096;

constexpr int RING_OFF = 0, RING_BYTES = 131072;
constexpr int LDSCTL_OFF = RING_BYTES, MISC_OFF = LDSCTL_OFF + 320;
constexpr int LDS_BYTES = 147456;
static_assert(MISC_OFF + 128 <= LDS_BYTES, "LDS map");
#define GAS __attribute__((address_space(1)))
#define LAS __attribute__((address_space(3)))
typedef unsigned short bf16;
typedef unsigned v4u __attribute__((ext_vector_type(4)));
typedef float f32x4 __attribute__((ext_vector_type(4)));
typedef short bf16x8 __attribute__((ext_vector_type(8)));
typedef GAS unsigned gu32;
typedef GAS unsigned long long gu64;
#define RLX_AGENT __ATOMIC_RELAXED, __HIP_MEMORY_SCOPE_AGENT
#define LDS_WAIT() asm volatile("s_waitcnt lgkmcnt(0)" ::: "memory")
#define VM_WAIT() asm volatile("s_waitcnt vmcnt(0)" ::: "memory")
__device__ __forceinline__ unsigned long long rt() { return __builtin_amdgcn_s_memrealtime(); }
__device__ __forceinline__ unsigned f2bf(float f) { unsigned u = __builtin_bit_cast(unsigned, f); return (u + 0x7fffu + ((u >> 16) & 1u)) >> 16; }
__device__ __forceinline__ unsigned pk2(float lo, float hi) { return f2bf(lo) | (f2bf(hi) << 16); }

#define XB_TMO      128
#define XB_XCNT(j)  (256  + 64 * (j))
#define XB_XSUB(j)  (1280 + 64 * (j))
#define XB_XGEN(j)  (2304 + 64 * (j))
#define XB_TOP      3328
#define XB_TOPGEN   3392
#define XCD_BAR_WORDS 3456
#define XB_SPIN_CAP (1u << 18)

__device__ __forceinline__ unsigned xb_ld(unsigned* p)              { return __hip_atomic_load(p, __ATOMIC_RELAXED, __HIP_MEMORY_SCOPE_AGENT); }
__device__ __forceinline__ unsigned xb_add(unsigned* p, unsigned v) { return __hip_atomic_fetch_add(p, v, __ATOMIC_RELAXED, __HIP_MEMORY_SCOPE_AGENT); }
__device__ __forceinline__ unsigned xb_xcc_id() { return (unsigned)__builtin_amdgcn_s_getreg((3 << 11) | 20) & 0xFu; }
#define XB_SPIN(cond, bar) do { unsigned _sp = 0; while (cond) { __builtin_amdgcn_s_sleep(1); \
    if ((++_sp & 255u) == 0u) { if (xb_ld(&(bar)[XB_TMO])) break; if (_sp > XB_SPIN_CAP) { atomicAdd(&(bar)[XB_TMO], 1u); break; } } } } while (0)

struct XcdBarrier {
    unsigned* bar; unsigned x;
    volatile LAS unsigned* st;
};

__device__ __forceinline__ XcdBarrier xcd_barrier_post(unsigned* bar, volatile LAS unsigned* st) {
    XcdBarrier b; b.bar = bar; b.x = xb_xcc_id(); b.st = st;
    if (threadIdx.x == 0) (void)xb_add(&bar[XB_XCNT(b.x)], 1u);
    return b;
}
__device__ __forceinline__ void xcd_barrier_complete(unsigned* bar, unsigned x, unsigned& nloc, unsigned& nx) {
    const unsigned G = gridDim.x * gridDim.y * gridDim.z;
    unsigned sum, cnt, mine, sp = 0u;
    for (;;) {
        sum = 0u; cnt = 0u; mine = 0u;
#pragma unroll
        for (unsigned j = 0; j < 16; ++j) { const unsigned c = xb_ld(&bar[XB_XCNT(j)]); sum += c; cnt += (c > 0u) ? 1u : 0u; mine = (j == x) ? c : mine; }
        if (sum == G) break;
        __builtin_amdgcn_s_sleep(1);
        if ((++sp & 255u) == 0u) { if (xb_ld(&bar[XB_TMO])) break; if (sp > XB_SPIN_CAP) { atomicAdd(&bar[XB_TMO], 1u); break; } }
    }
    nloc = mine > 0u ? mine : 1u; nx = cnt > 0u ? cnt : 1u;
}

__device__ __forceinline__ void xcd_barrier(const XcdBarrier& b) {
    asm volatile("s_waitcnt vmcnt(0)" ::: "memory");
    __syncthreads();
    if (threadIdx.x == 0) {
        unsigned* bar = b.bar;
        __builtin_amdgcn_s_waitcnt(0);
        unsigned nloc = b.st[0], nx = b.st[1];
        if (nloc == 0u) { xcd_barrier_complete(bar, b.x, nloc, nx); b.st[0] = nloc; b.st[1] = nx; }
        const unsigned old = xb_add(&bar[XB_XSUB(b.x)], 1u);
        const unsigned gen = old / nloc;
        if (old + 1u == (gen + 1u) * nloc) {
            __builtin_amdgcn_fence(__ATOMIC_RELEASE, "agent");
            asm volatile("s_waitcnt vmcnt(0)" ::: "memory");
            const unsigned og = xb_add(&bar[XB_TOP], 1u);
            const unsigned tg = og / nx;
            if (og + 1u == (tg + 1u) * nx) xb_add(&bar[XB_TOPGEN], 1u);
            else XB_SPIN(xb_ld(&bar[XB_TOPGEN]) == tg, bar);
            __builtin_amdgcn_fence(__ATOMIC_ACQUIRE, "agent");
            xb_add(&bar[XB_XGEN(b.x)], 1u);
            asm volatile("s_waitcnt vmcnt(0)" ::: "memory");
        } else {
            XB_SPIN(xb_ld(&bar[XB_XGEN(b.x)]) == gen, bar);
            __builtin_amdgcn_fence(__ATOMIC_ACQUIRE, "agent");
            asm volatile("s_waitcnt vmcnt(0)" ::: "memory");
        }
    }
    __syncthreads();
}
struct Args { const float* in[23]; float* out; unsigned char* ws; int ph_lo, ph_hi; };
struct Frame {
    LAS unsigned char* lds;
    volatile LAS unsigned* MISC;
    gu32* ctl;
    unsigned char* ws;
    int tid, lane, wave;
    int vcu, G;
};
__device__ __forceinline__ float wave_sum(float v) {
#pragma unroll
    for (int o = 1; o < 64; o <<= 1) v += __shfl_xor(v, o);
    return v;
}
__device__ __forceinline__ float bf_lo(unsigned w) { return __uint_as_float(w << 16); }
__device__ __forceinline__ float bf_hi(unsigned w) { return __uint_as_float(w & 0xffff0000u); }
__device__ __forceinline__ unsigned pkbf(float lo, float hi) { return pg8::cvt_pk_bf16(lo, hi); }
__device__ __forceinline__ f32x4 ld_xr4(const bf16* p) { const unsigned long long w = *(const GAS unsigned long long*)p; const unsigned a = (unsigned)w, b = (unsigned)(w >> 32); return (f32x4){bf_lo(a), bf_hi(a), bf_lo(b), bf_hi(b)}; }

struct GridOrder {
    int nM, nN, G, c; bool mapA;
    __device__ __forceinline__ bool next(int i, pg8::Unit& u) const {
        const long L = (long)i * G + c; if (L >= (long)nM * nN) return false;
        int pm, pn; pg8::tile_map((int)L, nM, nN, pm, pn); u.om = pm; u.pm = mapA ? pm + (pm >> 5) + 1 : pm; u.pn = pn; u.e = 0; return true; }
    __device__ __forceinline__ void a_ready(const pg8::Unit&) const {}
    __device__ __forceinline__ void done(const pg8::Unit&) const {}
};
struct InProjOrder {
    int G, c;
    __device__ __forceinline__ bool next(int i, pg8::Unit& u) const {
        const long L = (long)i * G + c; if (L >= 2304 + 9 * NB) return false;
        if (L < 2304) { int pm, pn; pg8::tile_map((int)L, 256, 9, pm, pn); u.pm = pm + (pm >> 5) + 1; u.pn = pn; }
        else { const int j = (int)L - 2304; u.pm = (j / 9) * 33; u.pn = j % 9; }
        u.om = u.pm; u.e = 0; return true; }
    __device__ __forceinline__ void a_ready(const pg8::Unit&) const {}
    __device__ __forceinline__ void done(const pg8::Unit&) const {}
};
struct CtxOrder {
    int nN, G, j; bool mapA;
    __device__ __forceinline__ bool next(int i, pg8::Unit& u) const {
        const long L = (long)i * G + j; if (L >= (long)NB * nN) return false;
        const int b = (int)L / nN; u.pn = (int)L - b * nN; u.om = b; u.pm = mapA ? b * 33 : b; u.e = 0; return true; }
    __device__ __forceinline__ void a_ready(const pg8::Unit&) const {}
    __device__ __forceinline__ void done(const pg8::Unit&) const {}
};
struct CtxSplitKOrder {
    int G, j;
    __device__ __forceinline__ bool next(int i, pg8::Unit& u) const {
        const long L = (long)i * G + j; if (L >= 64) return false;
        const int b = (int)L >> 3, r = (int)L & 7; u.pn = r & 3; u.e = r >> 2; u.pm = 2 * b + u.e; u.om = u.pm; return true; }
    __device__ __forceinline__ void a_ready(const pg8::Unit&) const {}
    __device__ __forceinline__ void done(const pg8::Unit&) const {}
};
struct MoeOrder {
    int nM, nN, G, c; int ts1, ts2, ts3, ts4, ts5, ts6, ts7;
    __device__ __forceinline__ bool next(int i, pg8::Unit& u) const {
        const long L = (long)i * G + c; if (L >= (long)nM * nN) return false;
        int pm, pn; pg8::tile_map((int)L, nM, nN, pm, pn); u.pm = pm; u.om = pm; u.pn = pn;
        u.e = (pm >= ts1) + (pm >= ts2) + (pm >= ts3) + (pm >= ts4) + (pm >= ts5) + (pm >= ts6) + (pm >= ts7); return true; }
    __device__ __forceinline__ void a_ready(const pg8::Unit&) const {}
    __device__ __forceinline__ void done(const pg8::Unit&) const {}
};

__device__ __forceinline__ void p0_item_load(const float* W, int N, int k0, int n0, int lane, float (&wv)[32]) {
#pragma unroll
    for (int i = 0; i < 32; ++i) { const int kk = 2 * i + (lane >> 5); wv[i] = W[(size_t)(k0 + kk) * N + n0 + (lane & 31)]; }
}
__device__ __forceinline__ void p0_item_store(const float (&wv)[32], bf16* WT, int Kd, int k0, int drow0, LAS float* scr, int lane, bool fine) {
#pragma unroll
    for (int i = 0; i < 32; ++i) { const int kk = 2 * i + (lane >> 5); scr[kk * 33 + (lane & 31)] = wv[i]; }
    LDS_WAIT(); asm volatile("" ::: "memory");
    const int c = lane & 7;
#pragma unroll
    for (int j = 0; j < 4; ++j) { const int n = (lane >> 3) + 8 * j; const LAS float* s = scr + (8 * c) * 33 + n;
        v4u o; o.x = pkbf(s[0 * 33], s[1 * 33]); o.y = pkbf(s[2 * 33], s[3 * 33]); o.z = pkbf(s[4 * 33], s[5 * 33]); o.w = pkbf(s[6 * 33], s[7 * 33]);
        const int nd = fine ? 8 * ((n & 15) >> 2) + 4 * (n >> 4) + (n & 3) : n;
        *(GAS v4u*)(WT + (size_t)(drow0 + nd) * Kd + k0 + 8 * c) = o; }
    LDS_WAIT(); asm volatile("" ::: "memory");
}
__device__ __forceinline__ void p0_transpose_item(const float* W, int N, bf16* WT, int Kd, int k0, int n0, int drow0, LAS float* scr, int lane, bool fine = false) {
    float wv[32]; p0_item_load(W, N, k0, n0, lane, wv); p0_item_store(wv, WT, Kd, k0, drow0, scr, lane, fine);
}
struct WItem { const float* W; bf16* WT; int N, Kd, k0, n0, d; float scale; };
__device__ __forceinline__ bool p0_pick(int& it, const float* W, int K, int N, bf16* WT, int maptype, int half, int nmat, int dstN, WItem& o, float scale = 1.0f) {
    const int nblk = N / 32, per = (K / 64) * nblk, nitems = per * nmat;
    if (it >= nitems) { it -= nitems; return false; }
    const int e = it / per, r = it - e * per, kb = r / nblk, nb = r - kb * nblk, k0 = 64 * kb, n0 = 32 * nb;
    o.W = W + (size_t)e * K * N; o.WT = WT + (size_t)e * dstN * K; o.scale = scale; o.N = N; o.Kd = K; o.k0 = k0; o.n0 = n0; o.d = maptype == 0 ? n0 : (n0 >> 7) * 256 + (n0 & 127) + half * 128;
    return true;
}
__device__ __forceinline__ bool p0_mats(int& it, const float* W, int K, int N, bf16* WT, int maptype, int half, int nmat, int dstN, LAS float* scr, int lane) {
    const int nblk = N / 32, per = (K / 64) * nblk, nitems = per * nmat;
    if (it >= nitems) { it -= nitems; return false; }
    const int e = it / per, r = it - e * per, kb = r / nblk, nb = r - kb * nblk, k0 = 64 * kb, n0 = 32 * nb;
    int d;
    if (maptype == 0) d = n0;
    else if (maptype == 1) { d = n0 < 512 ? n0 : n0 < 768 ? n0 + 512 : n0 < 1280 ? n0 - 256 : n0 < 1792 ? 1280 + ((n0 - 1280) >> 7) * 256 + ((n0 - 1280) & 127) : 1280 + ((n0 - 1792) >> 7) * 256 + 128 + ((n0 - 1792) & 127);
        if (d < 1280) d = (d & ~255) + ((d >> 5) & 1) * 128 + ((d >> 6) & 3) * 32; }
    else d = (n0 >> 7) * 256 + (n0 & 127) + half * 128;
    p0_transpose_item(W + (size_t)e * K * N, N, WT + (size_t)e * dstN * K, K, k0, n0, d, scr, lane, maptype == 1 && (n0 < 640));
    return true;
}
__device__ __forceinline__ void p0_prologue(const Args& a, const Frame& F) {
    float* mod = (float*)(F.ws + WS_MOD);
    { LAS float* sl = (LAS float*)(F.lds + RING_OFF); LAS float* red = sl + 9 * 1024;
      for (int idx = F.tid; idx < 9 * 1024; idx += NWAVES * 64) { const int r = idx >> 10, k = idx & 1023; const float v = r < 8 ? a.in[1][r * 1024 + k] : a.in[3][k]; sl[idx] = v / (1.0f + __expf(-v)); }
      __syncthreads();
      for (int task = blockIdx.x; task < 192; task += F.G) { const int i = task / 96, n0 = (task % 96) * 64;
          float acc[9];
#pragma unroll
          for (int r = 0; r < 9; ++r) acc[r] = 0.f;
          const float* wp = a.in[4] + ((size_t)i * 1024 + F.wave * 128) * NMODV + n0 + F.lane;
#pragma unroll 4
          for (int k = 0; k < 128; ++k) { const float wv = wp[(size_t)k * NMODV];
#pragma unroll
              for (int r = 0; r < 9; ++r) acc[r] += sl[r * 1024 + F.wave * 128 + k] * wv; }
#pragma unroll
          for (int r = 0; r < 9; ++r) red[(F.wave * 9 + r) * 64 + F.lane] = acc[r];
          __syncthreads();
          for (int idx = F.tid; idx < 9 * 64; idx += NWAVES * 64) { const int r = idx >> 6, l = idx & 63; float s = 0.f;
#pragma unroll
              for (int w = 0; w < 8; ++w) s += red[(w * 9 + r) * 64 + l];
              mod[(size_t)(i * 9 + r) * NMODV + n0 + l] = s + a.in[5][i * NMODV + n0 + l]; }
          __syncthreads(); }
    }
    { float* rt_ = (float*)(F.ws + WS_ROPE); const int gt = blockIdx.x * (NWAVES * 64) + F.tid;
      if (gt < 192 * 16) { const int p = gt >> 4, i = gt & 15; const float pos = (float)(p < 128 ? p : p - 128); const float freq = exp2f(-(float)i * (13.287712379549449f / 16.0f)); const float ang = pos * freq;
          rt_[gt * 2] = cosf(ang); rt_[gt * 2 + 1] = sinf(ang); } }
    __syncthreads();
    LAS float* scr = (LAS float*)(F.lds + RING_OFF + F.wave * 16384);
    const int gw = F.vcu * NWAVES + F.wave, NGW = F.G * NWAVES;
    for (int it0 = gw; it0 < 1152; it0 += NGW) { int it = it0; p0_mats(it, a.in[8], 1024, 2304, (bf16*)(F.ws + WS_WIN), 1, 0, 1, 2304, scr, F.lane); }
}
__device__ __forceinline__ void p0_late_weights(const Args& a, const Frame& F) {
    LAS float* scr = (LAS float*)(F.lds + RING_OFF + F.wave * 16384);
    const int gw = F.vcu * NWAVES + F.wave, NGW = F.G * NWAVES;
    constexpr int NITEMS = 512 + 3 * 1408 + 128 + 3 * 5632;
    const auto pick = [&](int it, WItem& o) {
        if (p0_pick(it, a.in[12], 1024, 1024, (bf16*)(F.ws + WS_WOUT), 0, 0, 1, 1024, o)) return;
        if (p0_pick(it, a.in[13], 1024, DFF, (bf16*)(F.ws + WS_WGU), 2, 0, 1, 2 * DFF, o, -1.4426950408889634f)) return;
        if (p0_pick(it, a.in[14], 1024, DFF, (bf16*)(F.ws + WS_WGU), 2, 1, 1, 2 * DFF, o)) return;
        if (p0_pick(it, a.in[15], DFF, 1024, (bf16*)(F.ws + WS_WD), 0, 0, 1, 1024, o, -0.6931471805599453f)) return;
        if (p0_pick(it, a.in[16], 256, 256, (bf16*)(F.ws + WS_WP), 0, 0, 4, 256, o)) return;
        if (p0_pick(it, a.in[20], 1024, DFE, (bf16*)(F.ws + WS_WEGU), 2, 0, NEXP, 2 * DFE, o, -1.4426950408889634f)) return;
        if (p0_pick(it, a.in[21], 1024, DFE, (bf16*)(F.ws + WS_WEGU), 2, 1, NEXP, 2 * DFE, o)) return;
        p0_pick(it, a.in[22], DFE, 1024, (bf16*)(F.ws + WS_WED), 0, 0, NEXP, 1024, o, -0.6931471805599453f); };
    for (int it0 = gw; it0 < NITEMS; it0 += 2 * NGW) {
        const bool two = it0 + NGW < NITEMS; WItem A, B; pick(it0, A); pick(two ? it0 + NGW : it0, B);
        float wa[32], wb[32]; p0_item_load(A.W, A.N, A.k0, A.n0, F.lane, wa); if (two) p0_item_load(B.W, B.N, B.k0, B.n0, F.lane, wb);
#pragma unroll
        for (int i = 0; i < 32; ++i) { wa[i] *= A.scale; wb[i] *= B.scale; }
        p0_item_store(wa, A.WT, A.Kd, A.k0, A.d, scr, F.lane, false); if (two) p0_item_store(wb, B.WT, B.Kd, B.k0, B.d, scr, F.lane, false);
    }
}

template <int MODE> __device__ __forceinline__ void norm_mod_phase(const Args& a, const Frame& F, int wgi, int nwg) {
    const int gw = wgi * NWAVES + F.wave, NGW = nwg * NWAVES;
    constexpr int nrows = MODE == 0 ? MC : ML; const int rpw = (nrows + NGW - 1) / NGW;
    const float* mod = (const float*)(F.ws + WS_MOD); const float* ng = a.in[6] + (MODE == 0 ? 0 : 1024);
    constexpr int SH = MODE == 0 ? 0 : 3, SC = SH + 1;
    bf16* A = (bf16*)(F.ws + WS_A);
    int cur_r = -1; f32x4 gm[4], sh[4];
    int R1 = (gw + 1) * rpw; if (R1 > nrows) R1 = nrows;
    constexpr int NR = 4;
    struct Batch { f32x4 v[NR][4]; unsigned long long raw[NR][4]; int rr[NR]; };
    auto load = [&](Batch& B, const int Rg) {
#pragma unroll
        for (int q = 0; q < NR; ++q) { const int R = Rg + q < R1 ? Rg + q : R1 - 1; const float* src;
            if (MODE == 0) { const int b = R / SROW, s = R - b * SROW; if (s < CTXL) { src = a.in[2] + ((size_t)b * CTXL + s) * 1024; B.rr[q] = 8; } else { src = a.in[0] + ((size_t)b * SEQ + (s - CTXL)) * 1024; B.rr[q] = b; } }
            else { src = nullptr; B.rr[q] = R / SEQ; }
#pragma unroll
            for (int j = 0; j < 4; ++j) { if (MODE == 0) B.v[q][j] = *(const GAS f32x4*)(src + 4 * F.lane + 256 * j); else B.raw[q][j] = *(const GAS unsigned long long*)((const bf16*)(F.ws + WS_XR) + (size_t)R * 1024 + 4 * F.lane + 256 * j); } }
    };
    auto process = [&](Batch& B, const int Rg) {
#pragma unroll
        for (int q = 0; q < NR; ++q) { const int R = Rg + q; if (R < R1) {
            if (B.rr[q] != cur_r) { cur_r = B.rr[q];
#pragma unroll
                for (int j = 0; j < 4; ++j) { const int col = 4 * F.lane + 256 * j; const f32x4 g = *(const f32x4*)(ng + col), sc = *(const f32x4*)(mod + (size_t)cur_r * NMODV + SC * 1024 + col);
                    gm[j] = g * (sc + 1.0f); sh[j] = *(const f32x4*)(mod + (size_t)cur_r * NMODV + SH * 1024 + col); } }
            f32x4 v[4];
#pragma unroll
            for (int j = 0; j < 4; ++j) { if (MODE == 0) v[j] = B.v[q][j]; else { const unsigned lo = (unsigned)B.raw[q][j], hi = (unsigned)(B.raw[q][j] >> 32); v[j] = (f32x4){bf_lo(lo), bf_hi(lo), bf_lo(hi), bf_hi(hi)}; } }
            float ss = 0.f;
#pragma unroll
            for (int j = 0; j < 4; ++j) ss += (v[j].x * v[j].x + v[j].y * v[j].y) + (v[j].z * v[j].z + v[j].w * v[j].w);
            const float rstd = rsqrtf(wave_sum(ss) * (1.0f / 1024.0f) + EPS);
#pragma unroll
            for (int j = 0; j < 4; ++j) { const f32x4 o = v[j] * rstd * gm[j] + sh[j];
                const int c_ = 4 * F.lane + 256 * j; const size_t di = MODE == 1 ? ((size_t)((R >> 8) * 16 + (c_ >> 6)) * 16384 + (size_t)(R & 255) * 64 + (c_ & 63)) : ((size_t)R * 1024 + c_);
                *(GAS unsigned long long*)(A + di) = (unsigned long long)pkbf(o.x, o.y) | ((unsigned long long)pkbf(o.z, o.w) << 32); } } }
    };
    Batch BA, BB;
    int Rg = gw * rpw;
    if (Rg < R1) load(BA, Rg);
#pragma unroll 1
    for (; Rg < R1; Rg += 2 * NR) {
        const bool more = Rg + NR < R1;
        if (more) load(BB, Rg + NR);
        process(BA, Rg);
        if (more) { if (Rg + 2 * NR < R1) load(BA, Rg + 2 * NR); process(BB, Rg + NR); }
    }
}

__device__ __forceinline__ void unpack8(const v4u w, float (&v)[8]) { v[0] = bf_lo(w.x); v[1] = bf_hi(w.x); v[2] = bf_lo(w.y); v[3] = bf_hi(w.y); v[4] = bf_lo(w.z); v[5] = bf_hi(w.z); v[6] = bf_lo(w.w); v[7] = bf_hi(w.w); }
__device__ __forceinline__ v4u pack8(const float (&v)[8]) { v4u w; w.x = pkbf(v[0], v[1]); w.y = pkbf(v[2], v[3]); w.z = pkbf(v[4], v[5]); w.w = pkbf(v[6], v[7]); return w; }
__device__ __forceinline__ v4u qk_head(const v4u w, const float* g8, const float* ropeT, bool do_rope, int prow, int pcol, float scale, int lane) {
    float v[8]; unpack8(w, v); float ss = 0.f;
#pragma unroll
    for (int e = 0; e < 8; ++e) ss += v[e] * v[e];
    ss += __shfl_xor(ss, 1); ss += __shfl_xor(ss, 2); ss += __shfl_xor(ss, 4);
    const float rstd = rsqrtf(ss * (1.0f / 64.0f) + EPS);
    const f32x4 g0 = *(const f32x4*)g8, g1 = *(const f32x4*)(g8 + 4);
    v[0] *= rstd * g0.x; v[1] *= rstd * g0.y; v[2] *= rstd * g0.z; v[3] *= rstd * g0.w; v[4] *= rstd * g1.x; v[5] *= rstd * g1.y; v[6] *= rstd * g1.z; v[7] *= rstd * g1.w;
    if (do_rope) {
        const int axis = (lane >> 2) & 1, pos = axis ? 128 + pcol : prow; const float* tp = ropeT + ((size_t)pos * 16 + (lane & 1) * 8) * 2; const bool second = (lane & 2) != 0;
#pragma unroll
        for (int e = 0; e < 8; ++e) { const float other = __shfl_xor(v[e], 2); const float c = tp[2 * e], s = tp[2 * e + 1];
            v[e] = second ? (other * s + v[e] * c) : (v[e] * c - other * s); }
    }
#pragma unroll
    for (int e = 0; e < 8; ++e) v[e] *= scale;
    return pack8(v);
}
__device__ __forceinline__ void gcu_prod(const bf16* zr, int lane, float (&o)[8]) {
    const v4u pr = *(const GAS v4u*)(zr + 1280 + lane * 8); unpack8(pr, o);
}
__device__ __forceinline__ void p3_postproc(const Args& a, const Frame& F) {
    const int gw = F.vcu * NWAVES + F.wave, NGW = F.G * NWAVES, lane = F.lane;
    bf16* Z = (bf16*)(F.ws + WS_R1);
    float w0[8], w1[8], w2[8];
    { const f32x4 c00 = *(const f32x4*)(a.in[11] + lane * 8), c01 = *(const f32x4*)(a.in[11] + lane * 8 + 4), c10 = *(const f32x4*)(a.in[11] + 512 + lane * 8), c11 = *(const f32x4*)(a.in[11] + 512 + lane * 8 + 4),
                  c20 = *(const f32x4*)(a.in[11] + 1024 + lane * 8), c21 = *(const f32x4*)(a.in[11] + 1024 + lane * 8 + 4);
      w0[0] = c00.x; w0[1] = c00.y; w0[2] = c00.z; w0[3] = c00.w; w0[4] = c01.x; w0[5] = c01.y; w0[6] = c01.z; w0[7] = c01.w;
      w1[0] = c10.x; w1[1] = c10.y; w1[2] = c10.z; w1[3] = c10.w; w1[4] = c11.x; w1[5] = c11.y; w1[6] = c11.z; w1[7] = c11.w;
      w2[0] = c20.x; w2[1] = c20.y; w2[2] = c20.z; w2[3] = c20.w; w2[4] = c21.x; w2[5] = c21.y; w2[6] = c21.z; w2[7] = c21.w; }
    for (int i = gw; i < NB * CTXL; i += NGW) { const int b = i / CTXL, s = i - b * CTXL; bf16* zr = Z + (size_t)(b * SROW + s) * ZP;
        float pv[8], cu[8], nx[8];
        if (s > 0) gcu_prod(zr - ZP, lane, pv); else {
#pragma unroll
            for (int e = 0; e < 8; ++e) pv[e] = 0.f; }
        gcu_prod(zr, lane, cu);
        if (s + 1 < CTXL) gcu_prod(zr + ZP, lane, nx); else {
#pragma unroll
            for (int e = 0; e < 8; ++e) nx[e] = 0.f; }
        { float gb[8], o[8]; unpack8(*(const GAS v4u*)(zr + 512 + lane * 8), gb);
#pragma unroll
          for (int e = 0; e < 8; ++e) o[e] = gb[e] * (w0[e] * pv[e] + w1[e] * cu[e] + w2[e] * nx[e]);
          *(GAS v4u*)(zr + 512 + lane * 8) = pack8(o); }
    }
    for (int ch = gw; ch < ML / 32; ch += NGW) {
        const int n0 = ch * 32, b = n0 / SEQ, t0 = n0 - b * SEQ; bf16* z0 = Z + (size_t)(b * SROW + CTXL + t0) * ZP;
        float prev[8], cur[8];
        if (t0 > 0) gcu_prod(z0 - ZP, lane, prev); else {
#pragma unroll
            for (int e = 0; e < 8; ++e) prev[e] = 0.f; }
        gcu_prod(z0, lane, cur);
        for (int i0 = 0; i0 < 32; i0 += 8) {
            v4u gcw[8], gbw[8];
#pragma unroll
            for (int q = 0; q < 8; ++q) { const int t = t0 + i0 + q; const bf16* zr = z0 + (size_t)(i0 + q) * ZP; const bf16* zn = (t + 1 < SEQ) ? zr + ZP : zr;
                gcw[q] = *(const GAS v4u*)(zn + 1280 + lane * 8); gbw[q] = *(const GAS v4u*)(zr + 512 + lane * 8); }
#pragma unroll
            for (int q = 0; q < 8; ++q) { const int t = t0 + i0 + q; bf16* zr = z0 + (size_t)(i0 + q) * ZP;
                float nxt[8]; { float x[8]; unpack8(gcw[q], x); const bool has = t + 1 < SEQ;
#pragma unroll
                    for (int e = 0; e < 8; ++e) nxt[e] = has ? x[e] : 0.f; }
                { float gb[8], o[8]; unpack8(gbw[q], gb);
#pragma unroll
                  for (int e = 0; e < 8; ++e) { o[e] = gb[e] * (w0[e] * prev[e] + w1[e] * cur[e] + w2[e] * nxt[e]); prev[e] = cur[e]; cur[e] = nxt[e]; }
                  *(GAS v4u*)(zr + 512 + lane * 8) = pack8(o); } }
        }
    }
}
template <int HW> __device__ __forceinline__ void p9_process(const unsigned long long (&raw)[16], const int base, const int rstart, const int t0, const float rs0, const float rs1, const float rs2,
                                                         const f32x4 gm, const f32x4 sh, f32x4 (&ring)[2 * HW], f32x4& sum, bf16* Pb, const int col) {
#pragma unroll
        for (int k = 0; k < 16; ++k) { const int r = rstart + base + k;
            const float rstd = __uint_as_float(__builtin_amdgcn_readlane(__float_as_uint(base + k < 64 ? rs0 : base + k < 128 ? rs1 : rs2), (base + k) & 63));
            const unsigned lo = (unsigned)raw[k], hi = (unsigned)(raw[k] >> 32);
            f32x4 a = (f32x4){bf_lo(lo), bf_hi(lo), bf_lo(hi), bf_hi(hi)} * rstd * gm + sh; if (r < 0 || r >= SEQ) a = (f32x4){0.f, 0.f, 0.f, 0.f};
            constexpr int W2 = 2 * HW; const int slot = k % W2;
            sum = sum + (a - ring[slot]); ring[slot] = a;
            const int t = r - HW + 1;
            if (t >= t0 && t < t0 + 128) { const int lo_t = t - HW < 0 ? 0 : t - HW, hi_t = t + HW > SEQ ? SEQ : t + HW; const float inv = 1.0f / (float)(hi_t - lo_t);
                const f32x4 c = ring[(k + W2 - HW + 1) % W2]; const f32x4 p = sum * inv - c;
                *(GAS unsigned long long*)(Pb + (size_t)t * 1024 + col) = (unsigned long long)pkbf(p.x, p.y) | ((unsigned long long)pkbf(p.z, p.w) << 32); } }
}
template <int HW> __device__ __forceinline__ void p9_task(const bf16* xb, const float* ssq_b, bf16* Pb, int t0, const f32x4 gm, const f32x4 sh, int col, int lane) {
    const int rstart = t0 - HW;
    unsigned long long rawA[16], rawB[16];
#define P9_LOAD(raw, base_) do { _Pragma("unroll") for (int k = 0; k < 16; ++k) { const int r_ = rstart + (base_) + k; const int rc_ = r_ < 0 ? 0 : r_ >= SEQ ? SEQ - 1 : r_; raw[k] = *(const GAS unsigned long long*)(xb + (size_t)rc_ * 1024 + col); } } while (0)
    P9_LOAD(rawA, 0);
    float rs0, rs1, rs2;
    { const int r0 = rstart + lane, r1 = rstart + 64 + lane, r2 = rstart + 128 + lane; float s0 = 0.f, s1 = 0.f, s2 = 0.f;
      if (r0 >= 0 && r0 < SEQ) {
#pragma unroll
          for (int k = 0; k < 4; ++k) { const f32x4 v = *(const f32x4*)(ssq_b + (size_t)r0 * 16 + 4 * k); s0 += (v.x + v.y) + (v.z + v.w); } }
      if (r1 >= 0 && r1 < SEQ) {
#pragma unroll
          for (int k = 0; k < 4; ++k) { const f32x4 v = *(const f32x4*)(ssq_b + (size_t)r1 * 16 + 4 * k); s1 += (v.x + v.y) + (v.z + v.w); } }
      if (lane < 16 && r2 >= 0 && r2 < SEQ) {
#pragma unroll
          for (int k = 0; k < 4; ++k) { const f32x4 v = *(const f32x4*)(ssq_b + (size_t)r2 * 16 + 4 * k); s2 += (v.x + v.y) + (v.z + v.w); } }
      rs0 = rsqrtf(s0 * (1.0f / 1024.0f) + EPS); rs1 = rsqrtf(s1 * (1.0f / 1024.0f) + EPS); rs2 = rsqrtf(s2 * (1.0f / 1024.0f) + EPS); }
    f32x4 ring[2 * HW];
#pragma unroll
    for (int k = 0; k < 2 * HW; ++k) ring[k] = (f32x4){0.f, 0.f, 0.f, 0.f};
    f32x4 sum = (f32x4){0.f, 0.f, 0.f, 0.f};
#pragma unroll 1
    for (int base = 0; base < 144; base += 32) {
        const bool more = base + 16 < 144;
        if (more) P9_LOAD(rawB, base + 16);
        p9_process<HW>(rawA, base, rstart, t0, rs0, rs1, rs2, gm, sh, ring, sum, Pb, col);
        if (more) { if (base + 32 < 144) P9_LOAD(rawA, base + 32); p9_process<HW>(rawB, base + 16, rstart, t0, rs0, rs1, rs2, gm, sh, ring, sum, Pb, col); }
    }
#undef P9_LOAD
}
__device__ __forceinline__ void p9_pool(const Args& a, const Frame& F) {
    const float* mod = (const float*)(F.ws + WS_MOD) + (size_t)9 * NMODV; const float* ng = a.in[6] + 2 * 1024;
    bf16* P = (bf16*)(F.ws + WS_A); const bf16* X = (const bf16*)(F.ws + WS_XR); const float* ssq = (const float*)(F.ws + WS_SSQ);
    const int gw = F.vcu * NWAVES + F.wave, NGW = F.G * NWAVES;
    { const int gt = blockIdx.x * (NWAVES * 64) + F.tid; if (gt < NB * 1024) ((float*)(F.ws + WS_GSC))[gt] = mod[(size_t)(gt >> 10) * NMODV + 2 * 1024 + (gt & 1023)] * a.in[17][gt & 1023]; }
    for (int task = gw; task < (ML / 128) * 4; task += NGW) {
        const int rb = task >> 2, g = task & 3, n0 = rb * 128, b = n0 / SEQ, t0 = n0 - b * SEQ; const int col = g * 256 + 4 * F.lane;
        const f32x4 gg = *(const f32x4*)(ng + col), sc = *(const f32x4*)(mod + (size_t)b * NMODV + 1024 + col), sh = *(const f32x4*)(mod + (size_t)b * NMODV + col); const f32x4 gm = gg * (sc + 1.0f);
        const bf16* xb = X + (size_t)b * SEQ * 1024; const float* sb = ssq + (size_t)b * SEQ * 16; bf16* Pb = P + (size_t)b * SEQ * 1024;
        if (g == 0) p9_task<1>(xb, sb, Pb, t0, gm, sh, col, F.lane); else if (g == 1) p9_task<2>(xb, sb, Pb, t0, gm, sh, col, F.lane);
        else if (g == 2) p9_task<4>(xb, sb, Pb, t0, gm, sh, col, F.lane); else p9_task<8>(xb, sb, Pb, t0, gm, sh, col, F.lane);
    }
}

__device__ __forceinline__ void p11a_router(const Args& a, const Frame& F) {
    LAS v4u* Wh = (LAS v4u*)(F.lds + RING_OFF); LAS v4u* Wl = Wh + 2048;
    LAS float* gms = (LAS float*)(F.lds + RING_OFF + 65536); LAS float* shs = gms + 1024;
    LAS int* e1s = (LAS int*)(F.lds + RING_OFF + 65536 + 8192); LAS int* e2s = e1s + 256;
    LAS unsigned long long* bm = (LAS unsigned long long*)(F.lds + RING_OFF + 65536 + 8192 + 2048);
    const float* mod = (const float*)(F.ws + WS_MOD) + (size_t)9 * NMODV; const float* ng = a.in[6] + 3 * 1024;
    const bf16* X = (const bf16*)(F.ws + WS_XR); bf16* A = (bf16*)(F.ws + WS_A);
    unsigned* hist = (unsigned*)(F.ws + WS_HIST); unsigned* toke = (unsigned*)(F.ws + WS_TOKE); unsigned* tokr = (unsigned*)(F.ws + WS_TOKR); float* tokp = (float*)(F.ws + WS_TOKP);
    for (int idx = F.tid; idx < 2048; idx += NWAVES * 64) { const int e = idx & 15, kg = (idx >> 4) & 3, st = idx >> 6; v4u h = (v4u){0u, 0u, 0u, 0u}, l = h;
        if (e < 8) { const float* wp = a.in[18] + (size_t)(32 * st + 8 * kg) * 8 + e;
#pragma unroll
            for (int i = 0; i < 4; ++i) { const float w0 = wp[(2 * i) * 8], w1 = wp[(2 * i + 1) * 8]; const unsigned hw = pkbf(w0, w1); h[i] = hw; l[i] = pkbf(w0 - bf_lo(hw), w1 - bf_hi(hw)); } }
        Wh[idx] = h; Wl[idx] = l; }
    float rb[8];
#pragma unroll
    for (int e = 0; e < 8; ++e) rb[e] = a.in[19][e];
    const int tr = F.lane & 15, g = F.lane >> 4;
    for (int ch = F.vcu; ch < ML / 256; ch += F.G) {
        const int b = (ch * 256) / SEQ;
        __syncthreads();
        for (int idx = F.tid; idx < 1024; idx += NWAVES * 64) { gms[idx] = ng[idx] * (mod[(size_t)b * NMODV + 4 * 1024 + idx] + 1.0f); shs[idx] = mod[(size_t)b * NMODV + 3 * 1024 + idx]; }
        __syncthreads();
#pragma unroll 1
        for (int grp = 0; grp < 2; ++grp) {
            const int tl = F.wave * 32 + grp * 16 + tr, n = ch * 256 + tl;
            const bf16* xr = X + (size_t)n * 1024 + 8 * g; bf16* ar = A + (size_t)n * 1024 + 8 * g;
            v4u raw[32];
#pragma unroll
            for (int st = 0; st < 32; ++st) raw[st] = *(const GAS v4u*)(xr + 32 * st);
            float ss = 0.f;
#pragma unroll
            for (int st = 0; st < 32; ++st)
#pragma unroll
                for (int i = 0; i < 4; ++i) { const float x0 = bf_lo(raw[st][i]), x1 = bf_hi(raw[st][i]); ss += x0 * x0 + x1 * x1; }
            ss += __shfl_xor(ss, 16); ss += __shfl_xor(ss, 32);
            const float rstd = rsqrtf(ss * (1.0f / 1024.0f) + EPS);
            f32x4 acc0 = (f32x4){0.f, 0.f, 0.f, 0.f}, acc1 = acc0, acc2 = acc0;
#pragma unroll
            for (int st = 0; st < 32; ++st) {
                const f32x4 g0 = *(const LAS f32x4*)(gms + 32 * st + 8 * g), g1 = *(const LAS f32x4*)(gms + 32 * st + 8 * g + 4), h0 = *(const LAS f32x4*)(shs + 32 * st + 8 * g), h1 = *(const LAS f32x4*)(shs + 32 * st + 8 * g + 4);
                v4u rw = raw[st]; asm volatile("" : "+v"(rw));
                const f32x4 fa = (f32x4){bf_lo(rw[0]), bf_hi(rw[0]), bf_lo(rw[1]), bf_hi(rw[1])} * rstd * g0 + h0, fb = (f32x4){bf_lo(rw[2]), bf_hi(rw[2]), bf_lo(rw[3]), bf_hi(rw[3])} * rstd * g1 + h1;
                v4u hi; hi[0] = pkbf(fa[0], fa[1]); hi[1] = pkbf(fa[2], fa[3]); hi[2] = pkbf(fb[0], fb[1]); hi[3] = pkbf(fb[2], fb[3]);
                *(GAS v4u*)(ar + 32 * st) = hi;
                v4u lo; lo[0] = pkbf(fa[0] - bf_lo(hi[0]), fa[1] - bf_hi(hi[0])); lo[1] = pkbf(fa[2] - bf_lo(hi[1]), fa[3] - bf_hi(hi[1])); lo[2] = pkbf(fb[0] - bf_lo(hi[2]), fb[1] - bf_hi(hi[2])); lo[3] = pkbf(fb[2] - bf_lo(hi[3]), fb[3] - bf_hi(hi[3]));
                const v4u wh = Wh[st * 64 + F.lane], wl = Wl[st * 64 + F.lane];
                acc0 = __builtin_amdgcn_mfma_f32_16x16x32_bf16(__builtin_bit_cast(pg8::bf16x8, wh), __builtin_bit_cast(pg8::bf16x8, hi), acc0, 0, 0, 0);
                acc1 = __builtin_amdgcn_mfma_f32_16x16x32_bf16(__builtin_bit_cast(pg8::bf16x8, wl), __builtin_bit_cast(pg8::bf16x8, hi), acc1, 0, 0, 0);
                acc2 = __builtin_amdgcn_mfma_f32_16x16x32_bf16(__builtin_bit_cast(pg8::bf16x8, wh), __builtin_bit_cast(pg8::bf16x8, lo), acc2, 0, 0, 0);
                if ((st & 1) == 1) __builtin_amdgcn_sched_barrier(0);
            }
            const f32x4 acc = acc0 + (acc1 + acc2);
            float lg[8];
#pragma unroll
            for (int e = 0; e < 4; ++e) { lg[e] = acc[e] + rb[e]; lg[4 + e] = __shfl_xor(acc[e], 16) + rb[4 + e]; }
            int i1 = 0; float v1 = lg[0];
#pragma unroll
            for (int e = 1; e < 8; ++e) if (lg[e] > v1) { v1 = lg[e]; i1 = e; }
            int i2 = -1; float v2 = -INFINITY;
#pragma unroll
            for (int e = 0; e < 8; ++e) if (e != i1 && lg[e] > v2) { v2 = lg[e]; i2 = e; }
            if (i2 < 0) i2 = (i1 + 1) & 7;
            const float p1 = 1.0f / (1.0f + __expf(v2 - v1));
            if (g == 0) { e1s[tl] = i1; e2s[tl] = i2; tokp[n] = p1; }
        }
        __syncthreads();
        int my1 = 0, my2 = 0;
        if (F.wave < 4) { my1 = e1s[F.tid]; my2 = e2s[F.tid];
#pragma unroll
            for (int e = 0; e < 8; ++e) { const unsigned long long m = __ballot(my1 == e || my2 == e); if (F.lane == 0) bm[e * 4 + F.wave] = m; } }
        __syncthreads();
        if (F.wave < 4) { const unsigned long long lt = (1ull << F.lane) - 1ull; unsigned r1 = 0, r2 = 0;
#pragma unroll
            for (int w = 0; w < 4; ++w) { const unsigned long long m1 = bm[my1 * 4 + w], m2 = bm[my2 * 4 + w];
                if (w < F.wave) { r1 += __popcll(m1); r2 += __popcll(m2); } else if (w == F.wave) { r1 += __popcll(m1 & lt); r2 += __popcll(m2 & lt); } }
            const int n = ch * 256 + F.tid; toke[n] = (unsigned)my1 | ((unsigned)my2 << 8); tokr[n] = r1 | (r2 << 16); }
        if (F.tid < 8) { unsigned c = 0;
#pragma unroll
            for (int w = 0; w < 4; ++w) c += __popcll(bm[F.tid * 4 + w]);
            hist[ch * 8 + F.tid] = c; }
        __syncthreads();
    }
}
__device__ __forceinline__ void moe_offsets(const Frame& F) {
    LAS unsigned* pre = (LAS unsigned*)(F.lds + RING_OFF); LAS unsigned* offs = (LAS unsigned*)(F.lds + LDSCTL_OFF); LAS unsigned* tot = offs + 16;
    const unsigned* hist = (const unsigned*)(F.ws + WS_HIST);
    for (int idx = F.tid; idx < 2048; idx += NWAVES * 64) pre[idx] = hist[idx];
    __syncthreads();
    { const int e = F.wave;
      unsigned h[4], sm = 0;
#pragma unroll
      for (int i = 0; i < 4; ++i) { h[i] = pre[(4 * F.lane + i) * 8 + e]; sm += h[i]; }
      unsigned inc = sm;
#pragma unroll
      for (int o = 1; o < 64; o <<= 1) { const unsigned v = __shfl_up(inc, o); if (F.lane >= o) inc += v; }
      unsigned run = inc - sm;
#pragma unroll
      for (int i = 0; i < 4; ++i) { pre[(4 * F.lane + i) * 8 + e] = run; run += h[i]; }
      if (F.lane == 63) tot[e] = inc; }
    __syncthreads();
    if (F.tid == 0) { unsigned o = 0; for (int e = 0; e < 8; ++e) { offs[e] = o; o += (tot[e] + 255u) & ~255u; } offs[8] = o; }
    __syncthreads();
}
__device__ __forceinline__ void p11b_sort(const Args& a, const Frame& F) {
    const unsigned* toke = (const unsigned*)(F.ws + WS_TOKE); const unsigned* tokr = (const unsigned*)(F.ws + WS_TOKR);
    const int nf = blockIdx.x * (NWAVES * 64) + F.tid; unsigned ee0 = 0u, rr0 = 0u; if (nf < ML) { ee0 = toke[nf]; rr0 = tokr[nf]; }
    moe_offsets(F);
    LAS unsigned* pre = (LAS unsigned*)(F.lds + RING_OFF); LAS unsigned* offs = (LAS unsigned*)(F.lds + LDSCTL_OFF); LAS unsigned* tot = offs + 16; unsigned* toks = (unsigned*)(F.ws + WS_TOKS); unsigned* tokl = (unsigned*)(F.ws + WS_TOKL);
    if (blockIdx.x == 0) { for (int e = 0; e < NEXP; ++e) for (unsigned sl = offs[e] + tot[e] + F.tid; sl < offs[e + 1]; sl += NWAVES * 64) tokl[sl] = 0u; }
    for (int n = blockIdx.x * (NWAVES * 64) + F.tid; n < ML; n += F.G * NWAVES * 64) { const unsigned ee = n == nf ? ee0 : toke[n], rr = n == nf ? rr0 : tokr[n]; const int ch = n >> 8; const unsigned e1 = ee & 255u, e2 = ee >> 8;
        const unsigned s1 = offs[e1] + pre[ch * 8 + e1] + (rr & 0xffffu), s2 = offs[e2] + pre[ch * 8 + e2] + (rr >> 16);
        *(GAS unsigned long long*)(toks + 2 * n) = (unsigned long long)s1 | ((unsigned long long)s2 << 32); tokl[s1] = (unsigned)n; tokl[s2] = (unsigned)n; }
}
__device__ __forceinline__ void p14_final(const Args& a, const Frame& F) {
    const int gw = F.vcu * NWAVES + F.wave, NGW = F.G * NWAVES; const int rpw = (ML + NGW - 1) / NGW;
    const float* mod = (const float*)(F.ws + WS_MOD) + (size_t)9 * NMODV; const bf16* Y = (const bf16*)(F.ws + WS_R2);
    const unsigned* toks = (const unsigned*)(F.ws + WS_TOKS); const float* tokp = (const float*)(F.ws + WS_TOKP);
    f32x4 fg[4];
#pragma unroll
    for (int j = 0; j < 4; ++j) fg[j] = *(const f32x4*)(a.in[7] + 4 * F.lane + 256 * j);
    int cur_b = -1; f32x4 g2[4];
    int n1 = (gw + 1) * rpw; if (n1 > ML) n1 = ML;
    constexpr int NR = 4;
    for (int ng_ = gw * rpw; ng_ < n1; ng_ += NR) {
        f32x4 x[NR][4]; unsigned long long y1[NR][4], y2[NR][4]; float p1[NR];
#pragma unroll
        for (int q = 0; q < NR; ++q) { const int n = ng_ + q < n1 ? ng_ + q : n1 - 1; const unsigned s1 = toks[2 * n], s2 = toks[2 * n + 1]; p1[q] = tokp[n];
#pragma unroll
            for (int j = 0; j < 4; ++j) { const int col = 4 * F.lane + 256 * j; x[q][j] = ld_xr4((const bf16*)(F.ws + WS_XR) + (size_t)n * 1024 + col);
                y1[q][j] = *(const GAS unsigned long long*)(Y + (size_t)s1 * 1024 + col); y2[q][j] = *(const GAS unsigned long long*)(Y + (size_t)s2 * 1024 + col); } }
#pragma unroll
        for (int q = 0; q < NR; ++q) { const int n = ng_ + q; if (n < n1) { const int b = n / SEQ;
            if (b != cur_b) { cur_b = b;
#pragma unroll
                for (int j = 0; j < 4; ++j) g2[j] = *(const f32x4*)(mod + (size_t)b * NMODV + 5 * 1024 + 4 * F.lane + 256 * j); }
            const float pa = p1[q], pb = 1.0f - pa; f32x4 v[4]; float ss = 0.f;
#pragma unroll
            for (int j = 0; j < 4; ++j) { const unsigned a0 = (unsigned)y1[q][j], a1 = (unsigned)(y1[q][j] >> 32), b0 = (unsigned)y2[q][j], b1 = (unsigned)(y2[q][j] >> 32);
                f32x4 m; m.x = pa * bf_lo(a0) + pb * bf_lo(b0); m.y = pa * bf_hi(a0) + pb * bf_hi(b0); m.z = pa * bf_lo(a1) + pb * bf_lo(b1); m.w = pa * bf_hi(a1) + pb * bf_hi(b1);
                v[j] = x[q][j] + g2[j] * m; ss += (v[j].x * v[j].x + v[j].y * v[j].y) + (v[j].z * v[j].z + v[j].w * v[j].w); }
            const float rstd = rsqrtf(wave_sum(ss) * (1.0f / 1024.0f) + EPS);
#pragma unroll
            for (int j = 0; j < 4; ++j) *(GAS f32x4*)(a.out + (size_t)n * 1024 + 4 * F.lane + 256 * j) = v[j] * rstd * fg[j]; } }
    }
}
__device__ __forceinline__ void ctx_norm2(const Args& a, const Frame& F) {
    const int gw = F.vcu * NWAVES + F.wave, NGW = F.G * NWAVES;
    const float* modc = (const float*)(F.ws + WS_MOD) + (size_t)8 * NMODV; const float* ng = a.in[6] + 1024;
    const bf16* X = (const bf16*)(F.ws + WS_XRC); bf16* A = (bf16*)(F.ws + WS_A1C);
    for (int R = gw; R < NB * CTXL; R += NGW) {
        f32x4 v[4]; float ss = 0.f;
#pragma unroll
        for (int j = 0; j < 4; ++j) { v[j] = ld_xr4(X + (size_t)R * 1024 + 4 * F.lane + 256 * j); ss += (v[j].x * v[j].x + v[j].y * v[j].y) + (v[j].z * v[j].z + v[j].w * v[j].w); }
        const float rstd = rsqrtf(wave_sum(ss) * (1.0f / 1024.0f) + EPS);
#pragma unroll
        for (int j = 0; j < 4; ++j) { const int col = 4 * F.lane + 256 * j; const f32x4 g = *(const f32x4*)(ng + col), sc = *(const f32x4*)(modc + 4 * 1024 + col), sh = *(const f32x4*)(modc + 3 * 1024 + col);
            const f32x4 o = v[j] * rstd * (g * (sc + 1.0f)) + sh;
            *(GAS unsigned long long*)(A + (size_t)R * 1024 + col) = (unsigned long long)pkbf(o.x, o.y) | ((unsigned long long)pkbf(o.z, o.w) << 32); }
    }
}
__device__ __forceinline__ void ctx_ffn_residual(const Args& a, const Frame& F) {
    const int gw = F.vcu * NWAVES + F.wave, NGW = F.G * NWAVES;
    const float* g2c = (const float*)(F.ws + WS_MOD) + (size_t)8 * NMODV + 5 * 1024;
    bf16* X = (bf16*)(F.ws + WS_XRC); const bf16* Y = (const bf16*)(F.ws + WS_YC);
    for (int R = gw; R < NB * CTXL; R += NGW) { const int b = R >> 8, r = R & 255;
#pragma unroll
        for (int j = 0; j < 4; ++j) { const int col = 4 * F.lane + 256 * j; const f32x4 x = ld_xr4(X + (size_t)R * 1024 + col), y0 = ld_xr4(Y + ((size_t)(2 * b) * 256 + r) * 1024 + col), y1 = ld_xr4(Y + ((size_t)(2 * b + 1) * 256 + r) * 1024 + col);
            const f32x4 o = x + *(const f32x4*)(g2c + col) * (y0 + y1);
            *(GAS unsigned long long*)(X + (size_t)R * 1024 + col) = (unsigned long long)pkbf(o.x, o.y) | ((unsigned long long)pkbf(o.z, o.w) << 32); }
    }
}
__global__ void __launch_bounds__(NWAVES * 64, 2) fwd_kernel(Args args) {
    extern __shared__ __attribute__((aligned(16))) unsigned char lds[];
    Frame F;
    F.lds = (LAS unsigned char*)lds;
    F.MISC = (volatile LAS unsigned*)(F.lds + MISC_OFF);
    F.tid = threadIdx.x; F.lane = F.tid & 63; F.wave = __builtin_amdgcn_readfirstlane(F.tid >> 6);
    F.G = gridDim.x; { const int bx = blockIdx.x; F.vcu = (F.G % 8 == 0) ? (bx % 8) * (F.G / 8) + bx / 8 : bx; }
    F.ws = args.ws; F.ctl = (gu32*)(args.ws + WS_CTL);
    for (int u = F.tid; u < (LDS_BYTES - LDSCTL_OFF) / 4; u += NWAVES * 64) ((LAS unsigned*)(F.lds + LDSCTL_OFF))[u] = 0u;
    __syncthreads();
    XcdBarrier bar; bar.bar = (unsigned*)(F.ctl + CW_BAR); bar.x = 0; bar.st = nullptr;
    if (!MK_PER_PHASE) bar = xcd_barrier_post((unsigned*)(F.ctl + CW_BAR), F.MISC + 8);
    const int lo = args.ph_lo, hi = args.ph_hi;
#define IN(k) (lo <= (k) && (k) < hi)
#define SEAM(k) do { if (IN(k) && IN((k) + 1)) xcd_barrier(bar); } while (0)
    bf16* const WA = (bf16*)(F.ws + WS_A); bf16* const R1 = (bf16*)(F.ws + WS_R1); bf16* const R2 = (bf16*)(F.ws + WS_R2); bf16* const XR = (bf16*)(F.ws + WS_XR);
    const float* const mod0 = (const float*)(F.ws + WS_MOD); const float* const mod1 = mod0 + (size_t)9 * NMODV;

#define PH(k, first, body) do { if (IN(k)) { RETID(); if (PROBE_DUP == (k)) { first; xcd_barrier(bar); } body; } SEAM(k); } while (0)
#define RETID() do { int t_ = threadIdx.x; asm volatile("" : "+v"(t_)); F.tid = t_; F.lane = t_ & 63; } while (0)
    constexpr int NS = PROBE_NOSTORE;
    PH(0, p0_prologue(args, F), p0_prologue(args, F));
    PH(1, norm_mod_phase<0>(args, F, F.vcu, F.G), norm_mod_phase<0>(args, F, F.vcu, F.G));
#define P2BODY(ns) { pg8::Gemm g{WA, (const bf16*)(F.ws + WS_WIN), 1024, 1024, 1024, 0, 0, nullptr}; InProjOrder S{F.G, (int)blockIdx.x}; pg8::EpiInProj E{R1, ZP, ns, args.in[9], args.in[10], (const float*)(F.ws + WS_ROPE), QSCALE}; \
        pg8::gemm_phase<pg8::EpiInProj, InProjOrder, true, true>(F.lds + RING_OFF, g, S, E); }
    PH(2, P2BODY(NS), P2BODY(0));
    float smax; { const float gq = fabsf(args.in[9][F.lane]), gk = fabsf(args.in[10][F.lane]); float mq = gq, mk = gk;
#pragma unroll
        for (int o = 1; o < 64; o <<= 1) { mq = fmaxf(mq, __shfl_xor(mq, o)); mk = fmaxf(mk, __shfl_xor(mk, o)); }
        smax = 64.0f * QSCALE * mq * mk * 1.03f + 0.5f; smax = __builtin_amdgcn_readfirstlane(smax); }
    const int nun4 = (attn_body::N_UNITS - F.vcu + F.G - 1) / F.G; const int conv_at = (F.vcu & 7) % (nun4 > 0 ? nun4 : 1);
    const int w_at = ((F.vcu + 4) & 7) % (nun4 > 0 ? nun4 : 1);
    const auto hook4 = [&](int ui) { if (ui == conv_at) p3_postproc(args, F); if (ui == w_at) { p0_late_weights(args, F); __syncthreads(); } };
#define P4BODY(Ob) { if (smax <= 40.0f) attn_body::attn_phase<8, true>((char*)lds + RING_OFF, (attn_body::bf16*)R1, (attn_body::bf16*)(Ob), F.G, F.vcu, smax, args.in[9], (const float*)(F.ws + WS_ROPE), hook4); \
        else attn_body::attn_phase<8, false>((char*)lds + RING_OFF, (attn_body::bf16*)R1, (attn_body::bf16*)(Ob), F.G, F.vcu, 0.f, args.in[9], (const float*)(F.ws + WS_ROPE), hook4); }
    PH(4, P4BODY(R2), P4BODY(R1));
#define P5BODY(ns) { pg8::Gemm g{R1, (const bf16*)(F.ws + WS_WOUT), 1024, ZP, 1024, 0, 0, nullptr}; GridOrder S{256, 4, F.G, (int)blockIdx.x, true}; pg8::EpiResB<true> E{args.in[0], XR, mod0 + 2 * 1024, NMODV, nullptr, ns, nullptr}; \
        pg8::gemm_phase<pg8::EpiResB<true>, GridOrder, true, true>(F.lds + RING_OFF, g, S, E); }
    PH(5, P5BODY(NS), P5BODY(0));
#define P6BODY() { const int ncw = (F.G + 7) / 8 < 32 ? (F.G + 7) / 8 : 32; const bool cw = (F.vcu & 7) == 0 && (F.vcu >> 3) < ncw; \
        if (cw) { pg8::Gemm g{R1, (const bf16*)(F.ws + WS_WOUT), 1024, ZP, 1024, 0, 0, nullptr}; CtxOrder S{4, ncw, F.vcu >> 3, true}; pg8::EpiResB<true> E{args.in[2], (bf16*)(F.ws + WS_XRC), mod0 + (size_t)8 * NMODV + 2 * 1024, 0, nullptr, 0, nullptr}; \
            pg8::gemm_phase<pg8::EpiResB<true>, CtxOrder, true, true>(F.lds + RING_OFF, g, S, E); } \
        else { const int below = (F.vcu + 7) / 8 < ncw ? (F.vcu + 7) / 8 : ncw; norm_mod_phase<1>(args, F, F.vcu - below, F.G - ncw); } }
    PH(6, P6BODY(), P6BODY());
#ifndef PV_ALIGN
#define PV_ALIGN true
#endif
#ifndef PV_SP2
#define PV_SP2 true
#endif
#define P7BODY(ns, AL, SP) { pg8::Gemm g{WA, (const bf16*)(F.ws + WS_WGU), 1024, 1024, 1024, 0, 0, nullptr}; GridOrder S{256, 22, F.G, (int)blockIdx.x, false}; pg8::EpiSwiGLU E{R1, DFF, ns}; \
        pg8::gemm_phase<pg8::EpiSwiGLU, GridOrder, AL, SP, true>(F.lds + RING_OFF, g, S, E); }
    PH(7, P7BODY(NS, PV_ALIGN, PV_SP2), P7BODY(0, true, true));
#define P8BODY(ns) { pg8::Gemm g{R1, (const bf16*)(F.ws + WS_WD), DFF, 64, DFF, 0, 0, nullptr}; GridOrder S{256, 4, F.G, (int)blockIdx.x, false}; pg8::EpiResB<false> E{XR, XR, mod0 + 5 * 1024, NMODV, nullptr, ns, (float*)(F.ws + WS_SSQ)}; \
        pg8::gemm_phase<pg8::EpiResB<false>, GridOrder, true, true, true>(F.lds + RING_OFF, g, S, E); }
    PH(8, P8BODY(1), P8BODY(0));
    PH(9, p9_pool(args, F), { p9_pool(args, F); ctx_norm2(args, F); });
#define P10BODY(ns) { pg8::Gemm g{WA, (const bf16*)(F.ws + WS_WP), 256, 1024, 256, 512, 0, nullptr}; GridOrder S{256, 4, F.G, (int)blockIdx.x, false}; pg8::EpiResB<false> E{XR, XR, (const float*)(F.ws + WS_GSC), 1024, nullptr, ns, nullptr}; \
        pg8::gemm_phase<pg8::EpiResB<false>, GridOrder, true, true>(F.lds + RING_OFF, g, S, E); }
    PH(10, P10BODY(1), P10BODY(0));
    PH(11, p11a_router(args, F), p11a_router(args, F));
    PH(12, p11b_sort(args, F), p11b_sort(args, F));
#define P13BODY(ns) { if (MK_PER_PHASE) moe_offsets(F); const LAS unsigned* offs = (const LAS unsigned*)(F.lds + LDSCTL_OFF); int ts[9]; \
        _Pragma("unroll") for (int e = 0; e < 9; ++e) ts[e] = __builtin_amdgcn_readfirstlane((int)(offs[e] >> 8)); \
        pg8::Gemm g{WA, (const bf16*)(F.ws + WS_WEGU), 1024, 1024, 1024, 0, (size_t)2 * DFE * 1024 * 2, (const unsigned*)(F.ws + WS_TOKL)}; MoeOrder S{ts[8], 11, F.G, (int)blockIdx.x, ts[1], ts[2], ts[3], ts[4], ts[5], ts[6], ts[7]}; pg8::EpiSwiGLU E{R1, DFE, ns}; \
        pg8::gemm_phase<pg8::EpiSwiGLU, MoeOrder, true, true, false, true>(F.lds + RING_OFF, g, S, E); \
          \
        { const int c0 = (int)(((long)ts[8] * 11) % F.G); pg8::Gemm gc{(const bf16*)(F.ws + WS_A1C), (const bf16*)(F.ws + WS_WGU), 1024, 1024, 1024, 0, 0, nullptr}; CtxOrder Sc{22, F.G, ((int)blockIdx.x - c0 + F.G) % F.G, false}; pg8::EpiSwiGLU Ec{(bf16*)(F.ws + WS_HC), DFF, ns}; \
          pg8::gemm_phase<pg8::EpiSwiGLU, CtxOrder, true, true>(F.lds + RING_OFF, gc, Sc, Ec); } }
    PH(13, P13BODY(NS), P13BODY(0));
#define P14BODY(ns) { if (MK_PER_PHASE) moe_offsets(F); const LAS unsigned* offs = (const LAS unsigned*)(F.lds + LDSCTL_OFF); int ts[9]; \
        _Pragma("unroll") for (int e = 0; e < 9; ++e) ts[e] = __builtin_amdgcn_readfirstlane((int)(offs[e] >> 8)); \
        pg8::Gemm g{R1, (const bf16*)(F.ws + WS_WED), DFE, 64, DFE, 0, (size_t)1024 * DFE * 2, nullptr}; MoeOrder S{ts[8], 4, F.G, (int)blockIdx.x, ts[1], ts[2], ts[3], ts[4], ts[5], ts[6], ts[7]}; pg8::EpiBf16 E{R2, 1024, ns}; \
        pg8::gemm_phase<pg8::EpiBf16, MoeOrder, true, true, true>(F.lds + RING_OFF, g, S, E); \
          \
        { const int c0 = (int)(((long)ts[8] * 4) % F.G); pg8::Gemm gc{(const bf16*)(F.ws + WS_HC), (const bf16*)(F.ws + WS_WD), DFF / 2, 64, DFF, 0, (size_t)(DFF / 2) * 2, nullptr}; CtxSplitKOrder Sc{F.G, ((int)blockIdx.x - c0 + F.G) % F.G}; \
          pg8::EpiBf16 Ec{(bf16*)(F.ws + WS_YC), 1024, ns}; \
          pg8::gemm_phase<pg8::EpiBf16, CtxSplitKOrder, true, true, true>(F.lds + RING_OFF, gc, Sc, Ec); } }
    PH(14, P14BODY(NS), P14BODY(0));
    if (IN(15)) { RETID(); p14_final(args, F); ctx_ffn_residual(args, F); }
#undef PH
#undef IN
#undef SEAM
}

extern "C" void kernel_launch(void* const* d_in, const int* in_sizes, int n_in, void* d_out, int out_size, void* d_ws, size_t ws_size, hipStream_t stream) {
    static int grid = 0;
    if (grid == 0) {
        if (n_in != 23 || in_sizes[0] != ML * DMODEL || out_size != ML * DMODEL || ws_size < WS_END) { fprintf(stderr, "kernel_launch: unexpected shapes / workspace (n_in %d, in0 %d, out %d, ws %zu); nothing launched\n", n_in, n_in > 0 ? in_sizes[0] : -1, out_size, ws_size); grid = -1; return; }
        int dev = 0, cus = 0, per_cu = 0;
        if (hipGetDevice(&dev) != hipSuccess || hipDeviceGetAttribute(&cus, hipDeviceAttributeMultiprocessorCount, dev) != hipSuccess) { fprintf(stderr, "kernel_launch: hipGetDevice / hipDeviceGetAttribute failed; nothing launched\n"); grid = -1; return; }
        if (hipFuncSetAttribute((const void*)fwd_kernel, hipFuncAttributeMaxDynamicSharedMemorySize, LDS_BYTES) != hipSuccess) { fprintf(stderr, "kernel_launch: hipFuncSetAttribute failed; nothing launched\n"); grid = -1; return; }
        if (hipOccupancyMaxActiveBlocksPerMultiprocessor(&per_cu, (const void*)fwd_kernel, NWAVES * 64, LDS_BYTES) != hipSuccess || per_cu < 1) { fprintf(stderr, "kernel_launch: occupancy query reports %d workgroups per CU\n", per_cu); }
        (void)hipGetLastError();
        grid = cus;
    }
    if (grid < 0) return;
    if (hipMemsetAsync((char*)d_ws + WS_CTL, 0, CTL_ZERO_BYTES, stream) != hipSuccess) { fprintf(stderr, "kernel_launch: hipMemsetAsync failed\n"); return; }
    Args a{};
    for (int i = 0; i < 23; ++i) a.in[i] = (const float*)d_in[i];
    a.out = (float*)d_out; a.ws = (unsigned char*)d_ws;
#if MK_PER_PHASE
    for (int p = 0; p < NPHASE; ++p) { a.ph_lo = p; a.ph_hi = p + 1; hipLaunchKernelGGL(fwd_kernel, dim3(grid), dim3(NWAVES * 64), LDS_BYTES, stream, a); }
#else
    a.ph_lo = 0; a.ph_hi = NPHASE;
    hipLaunchKernelGGL(fwd_kernel, dim3(grid), dim3(NWAVES * 64), LDS_BYTES, stream, a);
#endif
    const hipError_t le = hipPeekAtLastError();
    if (le != hipSuccess) fprintf(stderr, "kernel_launch: launch failed: %s\n", hipGetErrorName(le));
}
```
